# Optimizing an MI355X kernel written in HIP

```python
import math
import jax, jax.numpy as jnp
from jax import lax
import numpy as np

D_MODEL = 1024
BATCH = 8
SEQ = 4096
DEPTH = 2

RG_WIDTH = D_MODEL // 2
RG_BLOCKS = 8
RG_BLOCK = RG_WIDTH // RG_BLOCKS
CONV_WIDTH = 4
RG_C = 8.0
GLA_HEADS = 4
GLA_VDIM = D_MODEL // 2
GLA_KDIM = GLA_VDIM // 2
GLA_HK = GLA_KDIM // GLA_HEADS
GLA_HV = GLA_VDIM // GLA_HEADS
GLA_LOWRANK = 16
GLA_GATE_TAU = 16.0
GLA_CHUNK = 64
EVEN_IN = 2 * RG_WIDTH + 2 * GLA_KDIM + 2 * GLA_VDIM + GLA_LOWRANK
MIX_WIDTH = RG_WIDTH + GLA_VDIM

FOX_HEADS = 16
FOX_HD = D_MODEL // FOX_HEADS
FOX_BLOCK = 128
ODD_IN = 4 * D_MODEL + FOX_HEADS

D_FF = 4 * D_MODEL
N_EVEN = (DEPTH + 1) // 2
N_ODD = DEPTH // 2
ALPHA = (2 * DEPTH) ** 0.25
BETA = (8 * DEPTH) ** -0.25
LN_EPS = 1e-5
RMS_EPS = 1e-6

kernel_name = "hybrid_rglru_gla_fox_deepnorm_adaln"


def layer_norm(x, g, b):
    xf = x.astype(jnp.float32)
    mu = jnp.mean(xf, axis=-1, keepdims=True)
    var = jnp.mean(jnp.square(xf - mu), axis=-1, keepdims=True)
    return ((xf - mu) * lax.rsqrt(var + LN_EPS) * g.astype(jnp.float32)
            + b.astype(jnp.float32)).astype(x.dtype)


def rms_norm(x, g):
    xf = x.astype(jnp.float32)
    y = xf * lax.rsqrt(jnp.mean(xf * xf, axis=-1, keepdims=True) + RMS_EPS)
    return (y * g.astype(jnp.float32)).astype(x.dtype)


def ada_mod(c, w, b):
    m = (jax.nn.silu(c) @ w + b)[:, None, :]
    shift, scale, gate = jnp.split(m, 3, axis=-1)
    return shift, scale, 1.0 + gate


def causal_dwconv(x, w, b):
    k_len, ch = w.shape
    y = lax.conv_general_dilated(
        x, w[:, None, :].astype(x.dtype), window_strides=(1,),
        padding=[(k_len - 1, 0)], dimension_numbers=('NWC', 'WIO', 'NWC'),
        feature_group_count=ch)
    return y + b


def rg_lru(x, w_a, b_a, w_x, b_x, lam):
    bn, sn, _ = x.shape
    xf = x.astype(jnp.float32)
    xb = xf.reshape(bn, sn, RG_BLOCKS, RG_BLOCK)
    r = jax.nn.sigmoid(jnp.einsum('bsni,nij->bsnj', xb, w_a.astype(jnp.float32)).reshape(bn, sn, RG_WIDTH) + b_a)
    i = jax.nn.sigmoid(jnp.einsum('bsni,nij->bsnj', xb, w_x.astype(jnp.float32)).reshape(bn, sn, RG_WIDTH) + b_x)
    log_a = RG_C * r * jax.nn.log_sigmoid(lam.astype(jnp.float32))
    a = jnp.exp(log_a)
    u = jnp.sqrt(-jnp.expm1(2.0 * log_a)) * (i * xf)

    def combine(left, right):
        a1, h1 = left
        a2, h2 = right
        return a1 * a2, a2 * h1 + h2

    _, h = lax.associative_scan(combine, (a, u), axis=1)
    return h.astype(x.dtype)


def gla_chunked(q, k, v, log_alpha):
    bn, sn, nh, dk = q.shape
    dv = v.shape[-1]
    n_chunks = sn // GLA_CHUNK

    def blocks(t):
        return t.astype(jnp.float32).reshape(bn, n_chunks, GLA_CHUNK, nh, t.shape[-1]).transpose(1, 0, 3, 2, 4)

    qc = blocks(q) * (dk ** -0.5)
    kc = blocks(k)
    vc = blocks(v)
    bcum = jnp.cumsum(blocks(log_alpha), axis=3)
    b_last = bcum[:, :, :, -1:, :]
    q_dec = qc * jnp.exp(bcum)
    k_dec = kc * jnp.exp(-bcum)
    k_end = kc * jnp.exp(b_last - bcum)
    causal = jnp.tril(jnp.ones((GLA_CHUNK, GLA_CHUNK), dtype=bool))
    att = jnp.where(causal, jnp.einsum('nbhtd,nbhsd->nbhts', q_dec, k_dec), 0.0)
    o_intra = jnp.einsum('nbhts,nbhsv->nbhtv', att, vc)
    kv = jnp.einsum('nbhsd,nbhsv->nbhdv', k_end, vc)
    decay = jnp.exp(b_last[:, :, :, 0, :])

    def step(state, inp):
        dcy, kv_n = inp
        return dcy[..., None] * state + kv_n, state

    _, s_prev = lax.scan(step, jnp.zeros((bn, nh, dk, dv), jnp.float32), (decay, kv))
    o = o_intra + jnp.einsum('nbhtd,nbhdv->nbhtv', q_dec, s_prev)
    return o.transpose(1, 0, 3, 2, 4).reshape(bn, sn, nh, dv).astype(q.dtype)


def even_mixer(u, w_in, conv_w, conv_b, rg_wa, rg_ba, rg_wx, rg_bx, rg_lam,
               gla_w_up, gla_b_up, gla_norm_g, w_out):
    bn, sn, _ = u.shape
    proj = u @ w_in
    s1 = RG_WIDTH
    s2 = s1 + RG_WIDTH
    s3 = s2 + GLA_KDIM
    s4 = s3 + GLA_KDIM
    s5 = s4 + GLA_VDIM
    s6 = s5 + GLA_VDIM
    xr, yr, q, k, v, g, zl = jnp.split(proj, [s1, s2, s3, s4, s5, s6], axis=-1)
    h = rg_lru(causal_dwconv(xr, conv_w, conv_b), rg_wa, rg_ba, rg_wx, rg_bx, rg_lam)
    rg_out = h * jax.nn.gelu(yr)
    log_alpha = jax.nn.log_sigmoid((zl @ gla_w_up + gla_b_up).astype(jnp.float32)) / GLA_GATE_TAU
    o = gla_chunked(q.reshape(bn, sn, GLA_HEADS, GLA_HK),
                    k.reshape(bn, sn, GLA_HEADS, GLA_HK),
                    v.reshape(bn, sn, GLA_HEADS, GLA_HV),
                    log_alpha.reshape(bn, sn, GLA_HEADS, GLA_HK))
    o = rms_norm(o, gla_norm_g.reshape(GLA_HEADS, GLA_HV)) * jax.nn.silu(g).reshape(bn, sn, GLA_HEADS, GLA_HV)
    mix = jnp.concatenate([rg_out, o.reshape(bn, sn, GLA_VDIM)], axis=-1)
    return mix @ w_out


def fox_attention(u, w_in, b_f, q_norm_g, k_norm_g, w_out):
    bn, sn, _ = u.shape
    proj = u @ w_in
    q, k, v, g, fl = jnp.split(proj, [D_MODEL, 2 * D_MODEL, 3 * D_MODEL, 4 * D_MODEL], axis=-1)
    q = rms_norm(q.reshape(bn, sn, FOX_HEADS, FOX_HD), q_norm_g).transpose(0, 2, 1, 3) * (FOX_HD ** -0.5)
    k = rms_norm(k.reshape(bn, sn, FOX_HEADS, FOX_HD), k_norm_g).transpose(0, 2, 1, 3)
    v = v.reshape(bn, sn, FOX_HEADS, FOX_HD).transpose(0, 2, 1, 3)
    log_f = jax.nn.log_sigmoid((fl + b_f).astype(jnp.float32))
    f_cum = jnp.cumsum(log_f, axis=1).transpose(0, 2, 1)
    outs = []
    for blk in range(sn // FOX_BLOCK):
        t0 = blk * FOX_BLOCK
        t1 = t0 + FOX_BLOCK
        s = jnp.einsum('bhtd,bhsd->bhts', q[:, :, t0:t1], k[:, :, :t1]).astype(jnp.float32)
        s = s + f_cum[:, :, t0:t1, None] - f_cum[:, :, None, :t1]
        mask = (t0 + jnp.arange(FOX_BLOCK))[:, None] >= jnp.arange(t1)[None, :]
        p = jax.nn.softmax(jnp.where(mask, s, -jnp.inf), axis=-1)
        outs.append(jnp.einsum('bhts,bhsd->bhtd', p.astype(v.dtype), v[:, :, :t1]))
    o = jnp.concatenate(outs, axis=2).transpose(0, 2, 1, 3).reshape(bn, sn, D_MODEL)
    return (o * jax.nn.sigmoid(g)) @ w_out


def setup_inputs(seed: int = 0) -> dict:
    key = jax.random.key(seed)
    ks = jax.random.split(key, 32)
    D = D_MODEL

    def nrm(i, shape, scale):
        return scale * jax.random.normal(ks[i], shape, jnp.float32)

    lam_a = jax.random.uniform(ks[13], (N_EVEN, RG_WIDTH), jnp.float32, 0.9, 0.999)
    lam_root = lam_a ** (1.0 / RG_C)
    ev_lam = jnp.log(lam_root) - jnp.log1p(-lam_root)
    return {
        "x": nrm(0, (BATCH, SEQ, D), 1.0),
        "c": nrm(1, (BATCH, D), 1.0),
        "ada_w": nrm(2, (DEPTH, 2, D, 3 * D), 0.1 * D ** -0.5),
        "ada_b": nrm(3, (DEPTH, 2, 3 * D), 0.02),
        "ln_g": 1.0 + nrm(4, (DEPTH, 2, D), 0.05),
        "ln_b": nrm(5, (DEPTH, 2, D), 0.02),
        "ev_w_in": nrm(6, (N_EVEN, D, EVEN_IN), D ** -0.5),
        "ev_conv_w": nrm(7, (N_EVEN, CONV_WIDTH, RG_WIDTH), CONV_WIDTH ** -0.5),
        "ev_conv_b": nrm(8, (N_EVEN, RG_WIDTH), 0.02),
        "ev_rg_wa": nrm(9, (N_EVEN, RG_BLOCKS, RG_BLOCK, RG_BLOCK), RG_BLOCK ** -0.5),
        "ev_rg_ba": nrm(10, (N_EVEN, RG_WIDTH), 0.02),
        "ev_rg_wx": nrm(11, (N_EVEN, RG_BLOCKS, RG_BLOCK, RG_BLOCK), RG_BLOCK ** -0.5),
        "ev_rg_bx": nrm(12, (N_EVEN, RG_WIDTH), 0.02),
        "ev_rg_lam": ev_lam,
        "ev_gla_w_up": nrm(14, (N_EVEN, GLA_LOWRANK, GLA_KDIM), GLA_LOWRANK ** -0.5),
        "ev_gla_b_up": nrm(15, (N_EVEN, GLA_KDIM), 0.02),
        "ev_gla_norm_g": 1.0 + nrm(16, (N_EVEN, GLA_VDIM), 0.05),
        "ev_w_out": nrm(17, (N_EVEN, MIX_WIDTH, D), BETA * MIX_WIDTH ** -0.5),
        "od_w_in": nrm(18, (N_ODD, D, ODD_IN), D ** -0.5),
        "od_b_f": 3.0 + 3.0 * jax.random.uniform(ks[19], (N_ODD, FOX_HEADS), jnp.float32),
        "od_q_norm_g": 1.0 + nrm(20, (N_ODD, FOX_HD), 0.05),
        "od_k_norm_g": 1.0 + nrm(21, (N_ODD, FOX_HD), 0.05),
        "od_w_out": nrm(22, (N_ODD, D, D), BETA * D ** -0.5),
        "mlp_w1": nrm(23, (DEPTH, D, D_FF), D ** -0.5),
        "mlp_b1": nrm(24, (DEPTH, D_FF), 0.02),
        "mlp_w2": nrm(25, (DEPTH, D_FF, D), BETA * D_FF ** -0.5),
        "mlp_b2": nrm(26, (DEPTH, D), 0.02),
    }


def reference(x, c, ada_w, ada_b, ln_g, ln_b,
              ev_w_in, ev_conv_w, ev_conv_b, ev_rg_wa, ev_rg_ba, ev_rg_wx, ev_rg_bx, ev_rg_lam,
              ev_gla_w_up, ev_gla_b_up, ev_gla_norm_g, ev_w_out,
              od_w_in, od_b_f, od_q_norm_g, od_k_norm_g, od_w_out,
              mlp_w1, mlp_b1, mlp_w2, mlp_b2):
    for layer in range(DEPTH):
        shift, scale, gate = ada_mod(c, ada_w[layer, 0], ada_b[layer, 0])
        u = x * (1.0 + scale) + shift
        if layer % 2 == 0:
            e = layer // 2
            y = even_mixer(u, ev_w_in[e], ev_conv_w[e], ev_conv_b[e], ev_rg_wa[e], ev_rg_ba[e],
                           ev_rg_wx[e], ev_rg_bx[e], ev_rg_lam[e], ev_gla_w_up[e], ev_gla_b_up[e],
                           ev_gla_norm_g[e], ev_w_out[e])
        else:
            o = layer // 2
            y = fox_attention(u, od_w_in[o], od_b_f[o], od_q_norm_g[o], od_k_norm_g[o], od_w_out[o])
        x = layer_norm(ALPHA * x + gate * y, ln_g[layer, 0], ln_b[layer, 0])
        shift, scale, gate = ada_mod(c, ada_w[layer, 1], ada_b[layer, 1])
        u = x * (1.0 + scale) + shift
        y = jnp.square(jax.nn.relu(u @ mlp_w1[layer] + mlp_b1[layer])) @ mlp_w2[layer] + mlp_b2[layer]
        x = layer_norm(ALPHA * x + gate * y, ln_g[layer, 1], ln_b[layer, 1])
    return x
```

```cpp
#include <hip/hip_runtime.h>
#include <cstdio>
#include <cstdint>
#include <cmath>

namespace gold {
constexpr int D = 1024, B = 8, S = 4096, FF = 4096;
constexpr int RGW = 512, EVEN_IN = 2576, ODD_IN = 4112;
constexpr float ALPHA = 1.41421356237309515f;
constexpr float LN_EPS = 1e-5f, RMS_EPS = 1e-6f;

__device__ __forceinline__ float sigmoidf_(float x) { return 1.f / (1.f + expf(-x)); }
__device__ __forceinline__ float logsigmoidf_(float x) { return fminf(x, 0.f) - log1pf(expf(-fabsf(x))); }
__device__ __forceinline__ float siluf_(float x) { return x * sigmoidf_(x); }
__device__ __forceinline__ float gelu_tanh_(float x) { return 0.5f * x * (1.f + tanhf(0.7978845608028654f * (x + 0.044715f * x * x * x))); }

__global__ void k_ada(const float* c, const float* w, const float* bias, float* out) {
    int j = blockIdx.x * blockDim.x + threadIdx.x; int b = blockIdx.y;
    if (j >= 3 * D) return;
    float acc = 0.f;
    for (int k = 0; k < D; ++k) acc += siluf_(c[b * D + k]) * w[(size_t)k * 3 * D + j];
    out[(size_t)b * 3 * D + j] = acc + bias[j];
}
__global__ void k_modulate(const float* x, const float* mod, float* u) {
    size_t i = (size_t)blockIdx.x * blockDim.x + threadIdx.x; if (i >= (size_t)S * D) return;
    int col = (int)(i % D);
    u[i] = x[i] * (1.f + mod[D + col]) + mod[col];
}
__global__ void k_gemm(const float* A, const float* W, const float* bias, float* C, int M, int N, int K, int act) {
    __shared__ float sA[16][64 + 1]; __shared__ float sW[16][64 + 1];
    int tx = threadIdx.x & 15, ty = threadIdx.x >> 4; int m0 = blockIdx.y * 64, n0 = blockIdx.x * 64;
    float acc[4][4] = {};
    for (int k0 = 0; k0 < K; k0 += 16) {
        for (int e = threadIdx.x; e < 64 * 16; e += 256) { int r = e >> 4, kk = e & 15; sA[kk][r] = A[(size_t)(m0 + r) * K + k0 + kk]; }
        for (int e = threadIdx.x; e < 64 * 16; e += 256) { int kk = e >> 6, cc = e & 63; int n = n0 + cc; sW[kk][cc] = n < N ? W[(size_t)(k0 + kk) * N + n] : 0.f; }
        __syncthreads();
#pragma unroll
        for (int kk = 0; kk < 16; ++kk) {
            float a[4], w[4];
#pragma unroll
            for (int i = 0; i < 4; ++i) { a[i] = sA[kk][ty * 4 + i]; w[i] = sW[kk][tx * 4 + i]; }
#pragma unroll
            for (int i = 0; i < 4; ++i)
#pragma unroll
                for (int j = 0; j < 4; ++j) acc[i][j] += a[i] * w[j];
        }
        __syncthreads();
    }
    for (int i = 0; i < 4; ++i) for (int j = 0; j < 4; ++j) {
        int m = m0 + ty * 4 + i, n = n0 + tx * 4 + j; if (n >= N) continue;
        float v = acc[i][j] + (bias ? bias[n] : 0.f);
        if (act == 1) { v = fmaxf(v, 0.f); v = v * v; }
        C[(size_t)m * N + n] = v;
    }
}
__global__ void k_deepnorm(const float* x, const float* y, const float* mod, const float* g, const float* bb, float* out) {
    __shared__ float red[256];
    int row = blockIdx.x; float v[4]; float s = 0.f;
    for (int i = 0; i < 4; ++i) { int col = threadIdx.x + 256 * i; v[i] = ALPHA * x[(size_t)row * D + col] + (1.f + mod[2 * D + col]) * y[(size_t)row * D + col]; s += v[i]; }
    red[threadIdx.x] = s; __syncthreads();
    for (int o = 128; o > 0; o >>= 1) { if (threadIdx.x < o) red[threadIdx.x] += red[threadIdx.x + o]; __syncthreads(); }
    float mean = red[0] / D; __syncthreads();
    float q = 0.f; for (int i = 0; i < 4; ++i) { float d = v[i] - mean; q += d * d; }
    red[threadIdx.x] = q; __syncthreads();
    for (int o = 128; o > 0; o >>= 1) { if (threadIdx.x < o) red[threadIdx.x] += red[threadIdx.x + o]; __syncthreads(); }
    float rstd = rsqrtf(red[0] / D + LN_EPS);
    for (int i = 0; i < 4; ++i) { int col = threadIdx.x + 256 * i; out[(size_t)row * D + col] = (v[i] - mean) * rstd * g[col] + bb[col]; }
}
__global__ void k_conv(const float* proj, const float* cw, const float* cb, float* xc) {
    int i = blockIdx.x * blockDim.x + threadIdx.x; if (i >= S * RGW) return;
    int t = i / RGW, c = i % RGW; float acc = cb[c];
    for (int k = 0; k < 4; ++k) { int tt = t - 3 + k; if (tt >= 0) acc += cw[k * RGW + c] * proj[(size_t)tt * EVEN_IN + c]; }
    xc[i] = acc;
}
__global__ void k_rg_gates(const float* xc, const float* wa, const float* ba, const float* wx, const float* bx, const float* lam, float* a_out, float* u_out) {
    int i = blockIdx.x * blockDim.x + threadIdx.x; if (i >= S * RGW) return;
    int t = i / RGW, c = i % RGW, n = c >> 6, j = c & 63;
    float ra = 0.f, rx = 0.f;
    for (int ii = 0; ii < 64; ++ii) { float xv = xc[(size_t)t * RGW + n * 64 + ii]; ra += xv * wa[(n * 64 + ii) * 64 + j]; rx += xv * wx[(n * 64 + ii) * 64 + j]; }
    float r = sigmoidf_(ra + ba[c]), ig = sigmoidf_(rx + bx[c]);
    float log_a = 8.0f * r * logsigmoidf_(lam[c]);
    a_out[i] = expf(log_a);
    u_out[i] = sqrtf(-expm1f(2.f * log_a)) * (ig * xc[i]);
}
__global__ void k_rg_scan(const float* a, const float* u, const float* proj, float* mix) {
    int c = blockIdx.x * blockDim.x + threadIdx.x; if (c >= RGW) return;
    float h = 0.f;
    for (int t = 0; t < S; ++t) { h = a[(size_t)t * RGW + c] * h + u[(size_t)t * RGW + c]; mix[(size_t)t * D + c] = h * gelu_tanh_(proj[(size_t)t * EVEN_IN + RGW + c]); }
}
__global__ void k_gla_la(const float* proj, const float* wup, const float* bup, float* la) {
    int i = blockIdx.x * blockDim.x + threadIdx.x; if (i >= S * 256) return;
    int t = i >> 8, j = i & 255; float z = bup[j];
    for (int r = 0; r < 16; ++r) z += proj[(size_t)t * EVEN_IN + 2560 + r] * wup[r * 256 + j];
    la[i] = logsigmoidf_(z) * (1.f / 16.f);
}
__global__ void k_gla(const float* proj, const float* la, float* o_raw  ) {
    __shared__ float sq[64], sk[64], sal[64], part[256];
    int h = blockIdx.x; int half = threadIdx.x >> 7, dv = threadIdx.x & 127;
    float st[32]; for (int i = 0; i < 32; ++i) st[i] = 0.f;
    for (int t = 0; t < S; ++t) {
        const float* pr = proj + (size_t)t * EVEN_IN;
        if (threadIdx.x < 64) { sq[threadIdx.x] = pr[1024 + h * 64 + threadIdx.x] * 0.125f; }
        else if (threadIdx.x < 128) { int d = threadIdx.x - 64; sk[d] = pr[1280 + h * 64 + d]; }
        else if (threadIdx.x < 192) { int d = threadIdx.x - 128; sal[d] = expf(la[(size_t)t * 256 + h * 64 + d]); }
        float v = pr[1536 + h * 128 + dv];
        __syncthreads();
        float acc = 0.f;
#pragma unroll
        for (int i = 0; i < 32; ++i) { int dk = half * 32 + i; st[i] = sal[dk] * st[i] + sk[dk] * v; acc += sq[dk] * st[i]; }
        part[threadIdx.x] = acc; __syncthreads();
        if (half == 0) o_raw[(size_t)t * 512 + h * 128 + dv] = part[dv] + part[128 + dv];
        __syncthreads();
    }
}
__global__ void k_gla_out(const float* o_raw, const float* proj, const float* gnorm, float* mix) {
    int t = blockIdx.x, h = threadIdx.x >> 6, lane = threadIdx.x & 63;
    float v0 = o_raw[(size_t)t * 512 + h * 128 + lane], v1 = o_raw[(size_t)t * 512 + h * 128 + 64 + lane];
    float s = v0 * v0 + v1 * v1; for (int o = 1; o < 64; o <<= 1) s += __shfl_xor(s, o);
    float r = rsqrtf(s / 128.f + RMS_EPS);
    float g0 = proj[(size_t)t * EVEN_IN + 2048 + h * 128 + lane], g1 = proj[(size_t)t * EVEN_IN + 2048 + h * 128 + 64 + lane];
    mix[(size_t)t * D + 512 + h * 128 + lane] = v0 * r * gnorm[h * 128 + lane] * siluf_(g0);
    mix[(size_t)t * D + 512 + h * 128 + 64 + lane] = v1 * r * gnorm[h * 128 + 64 + lane] * siluf_(g1);
}
__global__ void k_qknorm(const float* proj, const float* qg, const float* kg, float* qn, float* kn) {
    int t = blockIdx.x, which = blockIdx.y, lane = threadIdx.x & 63;
    for (int h = threadIdx.x >> 6; h < 16; h += 4) {
        float v = proj[(size_t)t * ODD_IN + which * 1024 + h * 64 + lane];
        float s = v * v; for (int o = 1; o < 64; o <<= 1) s += __shfl_xor(s, o);
        float r = rsqrtf(s / 64.f + RMS_EPS);
        if (which == 0) qn[(size_t)t * D + h * 64 + lane] = v * r * qg[lane] * 0.125f; else kn[(size_t)t * D + h * 64 + lane] = v * r * kg[lane];
    }
}
__global__ void k_fcum(const float* proj, const float* bf, float* fcum  ) {
    int h = threadIdx.x; if (h >= 16) return; double acc = 0.0;
    for (int t = 0; t < S; ++t) { acc += (double)logsigmoidf_(proj[(size_t)t * ODD_IN + 4096 + h] + bf[h]); fcum[(size_t)h * S + t] = (float)acc; }
}
__global__ void k_fox(const float* qn, const float* kn, const float* proj, const float* fcum, float* og) {
    __shared__ float sp[4][64];
    int w = threadIdx.x >> 6, lane = threadIdx.x & 63; int t = blockIdx.x * 4 + w, h = blockIdx.y;
    float q[64];
#pragma unroll
    for (int d = 0; d < 64; ++d) q[d] = qn[(size_t)t * D + h * 64 + d];
    float ft = fcum[(size_t)h * S + t];
    float m = -INFINITY, l = 0.f, o = 0.f;
    for (int s0 = 0; s0 <= t; s0 += 64) {
        int s = s0 + lane; float sc = -INFINITY;
        if (s <= t) { const float4* kr = (const float4*)(kn + (size_t)s * D + h * 64); float acc = 0.f;
#pragma unroll
            for (int d = 0; d < 16; ++d) { float4 kv = kr[d]; acc += q[4 * d] * kv.x + q[4 * d + 1] * kv.y + q[4 * d + 2] * kv.z + q[4 * d + 3] * kv.w; }
            sc = acc + ft - fcum[(size_t)h * S + s]; }
        float cm = sc; for (int of = 1; of < 64; of <<= 1) cm = fmaxf(cm, __shfl_xor(cm, of));
        float mn = fmaxf(m, cm); float f = expf(m - mn); float p = (s <= t) ? expf(sc - mn) : 0.f;
        float ps = p; for (int of = 1; of < 64; of <<= 1) ps += __shfl_xor(ps, of);
        l = l * f + ps; o *= f; m = mn;
        sp[w][lane] = p; __builtin_amdgcn_wave_barrier();
        int cnt = min(64, t - s0 + 1);
        for (int j = 0; j < cnt; ++j) o += sp[w][j] * proj[(size_t)(s0 + j) * ODD_IN + 2048 + h * 64 + lane];
        __builtin_amdgcn_wave_barrier();
    }
    float gate = sigmoidf_(proj[(size_t)t * ODD_IN + 3072 + h * 64 + lane]);
    og[(size_t)t * D + h * 64 + lane] = (o / l) * gate;
}
}

extern "C" void kernel_launch(void* const* d_in, const int* in_sizes, int n_in, void* d_out, int out_size, void* d_ws, size_t ws_size, hipStream_t stream) {
    using namespace gold;
    const float* x = (const float*)d_in[0]; const float* c = (const float*)d_in[1]; const float* ada_w = (const float*)d_in[2]; const float* ada_b = (const float*)d_in[3];
    const float* ln_g = (const float*)d_in[4]; const float* ln_b = (const float*)d_in[5];
    const float* ev_w_in = (const float*)d_in[6]; const float* ev_conv_w = (const float*)d_in[7]; const float* ev_conv_b = (const float*)d_in[8];
    const float* ev_rg_wa = (const float*)d_in[9]; const float* ev_rg_ba = (const float*)d_in[10]; const float* ev_rg_wx = (const float*)d_in[11]; const float* ev_rg_bx = (const float*)d_in[12];
    const float* ev_rg_lam = (const float*)d_in[13]; const float* ev_gla_w_up = (const float*)d_in[14]; const float* ev_gla_b_up = (const float*)d_in[15]; const float* ev_gla_norm_g = (const float*)d_in[16];
    const float* ev_w_out = (const float*)d_in[17]; const float* od_w_in = (const float*)d_in[18]; const float* od_b_f = (const float*)d_in[19]; const float* od_qg = (const float*)d_in[20]; const float* od_kg = (const float*)d_in[21];
    const float* od_w_out = (const float*)d_in[22]; const float* mlp_w1 = (const float*)d_in[23]; const float* mlp_b1 = (const float*)d_in[24]; const float* mlp_w2 = (const float*)d_in[25]; const float* mlp_b2 = (const float*)d_in[26];
    float* out = (float*)d_out;
    float* ws = (float*)d_ws; size_t off = 0;
    auto alloc = [&](size_t n) { float* p = ws + off; off += (n + 63) / 64 * 64; return p; };
    float* mod = alloc((size_t)4 * B * 3 * D);
    float* xa = alloc((size_t)S * D); float* xb = alloc((size_t)S * D); float* u = alloc((size_t)S * D); float* y = alloc((size_t)S * D);
    float* proj = alloc((size_t)S * ODD_IN); float* hbuf = alloc((size_t)S * FF); float* mix = alloc((size_t)S * D);
    float* t1 = alloc((size_t)S * D); float* t2 = alloc((size_t)S * D); float* t3 = alloc((size_t)S * 512); float* fc = alloc((size_t)16 * S);
    for (int l = 0; l < 2; ++l) for (int s = 0; s < 2; ++s)
        k_ada<<<dim3(3 * D / 256, B), 256, 0, stream>>>(c, ada_w + (size_t)(l * 2 + s) * D * 3 * D, ada_b + (size_t)(l * 2 + s) * 3 * D, mod + (size_t)(l * 2 + s) * B * 3 * D);
    const int EW = (S * D + 255) / 256;
    for (int b = 0; b < B; ++b) {
        const float* xin = x + (size_t)b * S * D; float* xout = out + (size_t)b * S * D;
        auto M = [&](int l, int s) { return mod + ((size_t)(l * 2 + s) * B + b) * 3 * D; };
        k_modulate<<<EW, 256, 0, stream>>>(xin, M(0, 0), u);
        k_gemm<<<dim3((EVEN_IN + 63) / 64, S / 64), 256, 0, stream>>>(u, ev_w_in, nullptr, proj, S, EVEN_IN, D, 0);
        k_conv<<<S * RGW / 256, 256, 0, stream>>>(proj, ev_conv_w, ev_conv_b, t1);
        k_rg_gates<<<S * RGW / 256, 256, 0, stream>>>(t1, ev_rg_wa, ev_rg_ba, ev_rg_wx, ev_rg_bx, ev_rg_lam, t2, t2 + (size_t)S * RGW);
        k_rg_scan<<<RGW / 64, 64, 0, stream>>>(t2, t2 + (size_t)S * RGW, proj, mix);
        k_gla_la<<<S * 256 / 256, 256, 0, stream>>>(proj, ev_gla_w_up, ev_gla_b_up, t1);
        k_gla<<<4, 256, 0, stream>>>(proj, t1, t3);
        k_gla_out<<<S, 256, 0, stream>>>(t3, proj, ev_gla_norm_g, mix);
        k_gemm<<<dim3(D / 64, S / 64), 256, 0, stream>>>(mix, ev_w_out, nullptr, y, S, D, D, 0);
        k_deepnorm<<<S, 256, 0, stream>>>(xin, y, M(0, 0), ln_g, ln_b, xa);
        k_modulate<<<EW, 256, 0, stream>>>(xa, M(0, 1), u);
        k_gemm<<<dim3(FF / 64, S / 64), 256, 0, stream>>>(u, mlp_w1, mlp_b1, hbuf, S, FF, D, 1);
        k_gemm<<<dim3(D / 64, S / 64), 256, 0, stream>>>(hbuf, mlp_w2, mlp_b2, y, S, D, FF, 0);
        k_deepnorm<<<S, 256, 0, stream>>>(xa, y, M(0, 1), ln_g + D, ln_b + D, xb);
        k_modulate<<<EW, 256, 0, stream>>>(xb, M(1, 0), u);
        k_gemm<<<dim3((ODD_IN + 63) / 64, S / 64), 256, 0, stream>>>(u, od_w_in, nullptr, proj, S, ODD_IN, D, 0);
        k_qknorm<<<dim3(S, 2), 256, 0, stream>>>(proj, od_qg, od_kg, t1, t2);
        k_fcum<<<1, 64, 0, stream>>>(proj, od_b_f, fc);
        k_fox<<<dim3(S / 4, 16), 256, 0, stream>>>(t1, t2, proj, fc, mix);
        k_gemm<<<dim3(D / 64, S / 64), 256, 0, stream>>>(mix, od_w_out, nullptr, y, S, D, D, 0);
        k_deepnorm<<<S, 256, 0, stream>>>(xb, y, M(1, 0), ln_g + 2 * D, ln_b + 2 * D, xa);
        k_modulate<<<EW, 256, 0, stream>>>(xa, M(1, 1), u);
        k_gemm<<<dim3(FF / 64, S / 64), 256, 0, stream>>>(u, mlp_w1 + (size_t)D * FF, mlp_b1 + FF, hbuf, S, FF, D, 1);
        k_gemm<<<dim3(D / 64, S / 64), 256, 0, stream>>>(hbuf, mlp_w2 + (size_t)FF * D, mlp_b2 + D, y, S, D, FF, 0);
        k_deepnorm<<<S, 256, 0, stream>>>(xa, y, M(1, 1), ln_g + 3 * D, ln_b + 3 * D, xout);
    }
}
```

```cpp
#include <hip/hip_runtime.h>
#include <hip/hip_cooperative_groups.h>
#include <cstdio>
#include <cstdint>

namespace pg8 {
#define PG8_LAS __attribute__((address_space(3)))
typedef unsigned short bf16_t;
typedef short bf16x8 __attribute__((ext_vector_type(8)));
typedef float f32x4 __attribute__((ext_vector_type(4)));
typedef unsigned u32x4 __attribute__((ext_vector_type(4)));
constexpr int BM = 256, BK = 64, HALF = 128, HTB = HALF * BK * 2  , STAGE_BYTES = 8 * HTB, NXCD = 8, WGM = 8;

__host__ __device__ __forceinline__ int lds_byte(int r, int c) { const int st = (r >> 4) * 2 + (c >> 5), rr = r & 15, cc = c & 31, ob = rr * 64 + cc * 2; return st * 1024 + (ob ^ (((ob >> 9) & 1) << 5)); }
__host__ __device__ __forceinline__ void stage_rc(int b, int& R, int& C) { const int st = b / 1024, sb = b % 1024, swz = sb ^ (((sb >> 9) & 1) << 5); R = (st >> 1) * 16 + swz / 64; C = (st & 1) * 32 + (swz % 64) / 2; }
__host__ __device__ __forceinline__ int perm32(int rho) { const int n = rho >> 4, i = rho & 15; return 8 * (i >> 2) + 4 * n + (i & 3); }

struct Unit { int pm, pn; };
struct Gemm { const bf16_t* A; const bf16_t* Bt; int M, N, K; };

struct StaticOrder {
    int nM, nN, nwg, G, c;
    __host__ __device__ void init(int M, int N, int G_, int c_) { nM = M / BM; nN = N / BM; nwg = nM * nN; G = G_; c = c_; }
    __host__ __device__ bool next(int i, Unit& u) const {
        const long L = (long)i * G + c; if (L >= nwg) return false;
        int wgid = (int)L; { const int q = nwg / NXCD, r = nwg % NXCD, xcd = wgid % NXCD, off = wgid / NXCD; wgid = (xcd < r ? xcd * (q + 1) : r * (q + 1) + (xcd - r) * q) + off; }
        const int nig = WGM * nN, gid = wgid / nig, fm = gid * WGM, gsz = (nM - fm) < WGM ? (nM - fm) : WGM;
        u.pm = fm + ((wgid % nig) % gsz); u.pn = (wgid % nig) / gsz; return true;
    }
    __device__ __forceinline__ void a_ready(const Unit&) const {}
    __device__ __forceinline__ void done(const Unit&) const {}
};

__device__ __forceinline__ unsigned cvt_pk_bf16(float lo, float hi) { unsigned r; asm volatile("v_cvt_pk_bf16_f32 %0, %1, %2" : "=v"(r) : "v"(lo), "v"(hi)); return r; }
typedef float f32x2 __attribute__((ext_vector_type(2)));
__device__ __forceinline__ f32x2 gelu_pk(f32x2 v) {
    const f32x2 av = __builtin_elementwise_abs(v), d = av * 0.2316418882f + 1.0f;
    f32x2 t; t.x = __builtin_amdgcn_rcpf(d.x); t.y = __builtin_amdgcn_rcpf(d.y);
    f32x2 q = t * 0.5307027145f + (-0.7265760135f); q = q * t + 0.7107068705f; q = q * t + (-0.142248368f); q = q * t + 0.127414796f; q = q * t;
    const f32x2 s = (v * v) * (-0.72134752044f);
    f32x2 e; e.x = __builtin_amdgcn_exp2f(s.x); e.y = __builtin_amdgcn_exp2f(s.y);
    const f32x2 m = v * (q * e), r = v - m;
    f32x2 o; o.x = v.x < 0.f ? m.x : r.x; o.y = v.y < 0.f ? m.y : r.y; return o;
}

template <int ACT  > struct EpiBf16 {
    static constexpr bool PERM = true, AFTER_DRAIN = false, HEADPERM = false; static_assert(ACT == 0 || ACT == 1 || ACT == 2, "EpiBf16: ACT is 0 (none), 1 (gelu_pk) or 2 (relu^2)");
    bf16_t* O; int ldc; const float* bias; int split_cols; size_t split_stride; float scale0;
    __device__ __forceinline__ void operator()(const f32x4 (&acc)[2][2][4][2], const Unit& u, int wr, int wc, int fr, int fq) const {
        const int row0 = u.pm * BM + wr * 64 + fr; int colt = u.pn * BM; bf16_t* base = O;
        float sc = 1.f; if (split_cols) { const int t = colt / split_cols; base += (size_t)t * split_stride; colt -= t * split_cols; if (t == 0) sc = scale0; }
        const int col0 = colt + wc * 32 + 8 * fq, bcol0 = u.pn * BM + wc * 32 + 8 * fq;
        f32x4 bv[2][2];
#pragma unroll
        for (int bj = 0; bj < 2; ++bj)
#pragma unroll
            for (int n = 0; n < 2; ++n) bv[bj][n] = bias ? *(const f32x4*)(bias + bcol0 + bj * HALF + 4 * n) : (f32x4){0.f, 0.f, 0.f, 0.f};
#pragma unroll
        for (int ai = 0; ai < 2; ++ai)
#pragma unroll
            for (int m = 0; m < 4; ++m) { bf16_t* rowp = base + (size_t)(row0 + ai * HALF + m * 16) * ldc + col0;
#pragma unroll
                for (int bj = 0; bj < 2; ++bj) { f32x4 v0 = acc[ai][bj][m][0] + bv[bj][0], v1 = acc[ai][bj][m][1] + bv[bj][1];
                    if (ACT == 1) { f32x2 a = gelu_pk((f32x2){v0[0], v0[1]}), b = gelu_pk((f32x2){v0[2], v0[3]}), c = gelu_pk((f32x2){v1[0], v1[1]}), d = gelu_pk((f32x2){v1[2], v1[3]});
                        v0 = (f32x4){a.x, a.y, b.x, b.y}; v1 = (f32x4){c.x, c.y, d.x, d.y}; }
                    if (ACT == 2) { _Pragma("unroll") for (int e_ = 0; e_ < 4; ++e_) { const float a_ = fmaxf(v0[e_], 0.f), b_ = fmaxf(v1[e_], 0.f); v0[e_] = a_ * a_; v1[e_] = b_ * b_; } }
                    v0 = v0 * sc; v1 = v1 * sc; u32x4 w; w.x = cvt_pk_bf16(v0[0], v0[1]); w.y = cvt_pk_bf16(v0[2], v0[3]); w.z = cvt_pk_bf16(v1[0], v1[1]); w.w = cvt_pk_bf16(v1[2], v1[3]);
                    *(u32x4*)(rowp + bj * HALF) = w; } }
    }
};
typedef unsigned u32x2 __attribute__((ext_vector_type(2)));
struct EpiResid {
    static constexpr bool PERM = false, AFTER_DRAIN = false, HEADPERM = false;
    const float* base; float* out; const float* bias; const float* mod;
    __device__ __forceinline__ void operator()(const f32x4 (&acc)[2][2][4][2], const Unit& u, int wr, int wc, int fr, int fq) const {
        const int col0 = u.pn * BM + wc * 32 + 4 * fq; const float* mg = mod + (size_t)(u.pm >> 4) * 3072 + 2048;
        f32x4 gv[2][2], bv[2][2];
#pragma unroll
        for (int bj = 0; bj < 2; ++bj)
#pragma unroll
            for (int n = 0; n < 2; ++n) { gv[bj][n] = *(const f32x4*)(mg + col0 + bj * HALF + n * 16) + 1.0f; bv[bj][n] = bias ? *(const f32x4*)(bias + col0 + bj * HALF + n * 16) : (f32x4){0.f, 0.f, 0.f, 0.f}; }
#pragma unroll
        for (int ai = 0; ai < 2; ++ai)
#pragma unroll
            for (int m = 0; m < 4; ++m) { const size_t off = (size_t)(u.pm * BM + ai * HALF + wr * 64 + m * 16 + fr) * 1024 + col0;
#pragma unroll
                for (int bj = 0; bj < 2; ++bj)
#pragma unroll
                    for (int n = 0; n < 2; ++n) { const f32x4 bs = *(const f32x4*)(base + off + bj * HALF + n * 16);
                        *(f32x4*)(out + off + bj * HALF + n * 16) = bs * 1.41421356237309515f + gv[bj][n] * (acc[ai][bj][m][n] + bv[bj][n]); }
                if (m & 1) asm volatile("" ::: "memory"); }
    }
};
struct EpiQKVG {
    static constexpr bool PERM = true, AFTER_DRAIN = false, HEADPERM = true;
    bf16_t* qkvg; size_t stride; float* fl; const float* qg; const float* kg; float scale0;
    __device__ __forceinline__ void operator()(const f32x4 (&acc)[2][2][4][2], const Unit& u, int wr, int wc, int fr, int fq) const {
        const int row0 = u.pm * BM + wr * 64 + fr;
        if (u.pn == 16) {
            if (wc == 0 && fq < 2) {
#pragma unroll
                for (int ai = 0; ai < 2; ++ai)
#pragma unroll
                    for (int m = 0; m < 4; ++m) { float* p = fl + (size_t)(row0 + ai * HALF + m * 16) * 16 + 8 * fq; *(f32x4*)p = acc[ai][0][m][0]; *(f32x4*)(p + 4) = acc[ai][0][m][1]; }
            }
            return;
        }
        const int t = u.pn >> 2; bf16_t* dst = qkvg + (size_t)t * stride + (u.pn & 3) * 256 + wc * 64 + 8 * fq;
        f32x4 gv[2][2]; const float* gsrc = (t == 0) ? qg : kg; const float sc = (t == 0) ? scale0 : 1.0f;
        if (t < 2) {
#pragma unroll
            for (int bj = 0; bj < 2; ++bj)
#pragma unroll
                for (int n = 0; n < 2; ++n) gv[bj][n] = *(const f32x4*)(gsrc + 32 * bj + 8 * fq + 4 * n) * sc;
        }
#pragma unroll
        for (int ai = 0; ai < 2; ++ai)
#pragma unroll
            for (int m = 0; m < 4; ++m) { bf16_t* rowp = dst + (size_t)(row0 + ai * HALF + m * 16) * 1024;
                f32x4 v[2][2];
#pragma unroll
                for (int bj = 0; bj < 2; ++bj)
#pragma unroll
                    for (int n = 0; n < 2; ++n) v[bj][n] = acc[ai][bj][m][n];
                if (t < 2) { float ss = 0.f;
#pragma unroll
                    for (int bj = 0; bj < 2; ++bj)
#pragma unroll
                        for (int n = 0; n < 2; ++n) { const f32x4 x = v[bj][n]; ss += (x[0] * x[0] + x[1] * x[1]) + (x[2] * x[2] + x[3] * x[3]); }
                    ss += __shfl_xor(ss, 16); ss += __shfl_xor(ss, 32);
                    const float ri = 1.0f / sqrtf(ss * (1.0f / 64.0f) + 1e-6f);
#pragma unroll
                    for (int bj = 0; bj < 2; ++bj)
#pragma unroll
                        for (int n = 0; n < 2; ++n) v[bj][n] = v[bj][n] * ri * gv[bj][n]; }
#pragma unroll
                for (int bj = 0; bj < 2; ++bj) { u32x4 w; w.x = cvt_pk_bf16(v[bj][0][0], v[bj][0][1]); w.y = cvt_pk_bf16(v[bj][0][2], v[bj][0][3]); w.z = cvt_pk_bf16(v[bj][1][0], v[bj][1][1]); w.w = cvt_pk_bf16(v[bj][1][2], v[bj][1][3]);
                    *(u32x4*)(rowp + 32 * bj) = w; } }
    }
};

template <class Epi, class Sched, bool ALIGN_EPI = false, bool SP2 = false>
__device__ __forceinline__ void gemm_phase(PG8_LAS unsigned char* lds, const Gemm g, const Sched& S, const Epi& E) {
    int tid_g_ = threadIdx.x; asm volatile("" : "+v"(tid_g_)); const int tid = tid_g_, wid = __builtin_amdgcn_readfirstlane(tid >> 6), lane = tid & 63, wr = wid >> 2, wc = wid & 3, fr = lane & 15, fq = lane >> 4;
    const int K = g.K, nt = K / BK;
    unsigned voffA[2], voffB[2];
#pragma unroll
    for (int i = 0; i < 2; ++i) { int R, C; stage_rc(tid * 16 + i * 8192, R, C); const int Rb = Epi::HEADPERM ? (64 * (R >> 5) + perm32(R & 31)) : (Epi::PERM ? ((R & ~31) + perm32(R & 31)) : R);
        voffA[i] = (unsigned)(R * K + C) * 2u; voffB[i] = (unsigned)(Rb * K + C) * 2u; }
    const size_t kstep = (size_t)(BK * 2);
    const size_t hstep = (size_t)HALF * K * 2;
    const size_t tstep = 2 * hstep; const size_t hstepB = Epi::HEADPERM ? (size_t)32 * K * 2 : hstep;
    const unsigned ldsw = (unsigned)wid * 1024u;
    const int aoff = lds_byte(wr * 64 + fr, fq * 8), boff = lds_byte(wc * 32 + fr, fq * 8);
#define PG8_SA(b, h) (((b) * 2 + (h)) * HTB)
#define PG8_SB(b, h) ((4 + (b) * 2 + (h)) * HTB)
#define PG8_STAGE(bufoff, gbase, voff) do { _Pragma("unroll") for (int _i = 0; _i < 2; ++_i) \
        __builtin_amdgcn_global_load_lds((const unsigned*)((const char*)(gbase) + (voff)[_i]), (PG8_LAS unsigned*)(lds + (bufoff) + ldsw + _i * 8192), 16, 0, 0); } while (0)
#define PG8_LDA(dst, b, h) do { _Pragma("unroll") for (int m = 0; m < 4; ++m) _Pragma("unroll") for (int k = 0; k < 2; ++k) dst[m][k] = *(const PG8_LAS bf16x8*)(lds + PG8_SA(b, h) + aoff + m * 2048 + k * 1024); } while (0)
#define PG8_LDB(dst, b, h) do { _Pragma("unroll") for (int n = 0; n < 2; ++n) _Pragma("unroll") for (int k = 0; k < 2; ++k) dst[n][k] = *(const PG8_LAS bf16x8*)(lds + PG8_SB(b, h) + boff + n * 2048 + k * 1024); } while (0)
#define PG8_MMA(ai, bj, At, Bt) do { __builtin_amdgcn_s_setprio(1); _Pragma("unroll") for (int m = 0; m < 4; ++m) _Pragma("unroll") for (int n = 0; n < 2; ++n) _Pragma("unroll") for (int k = 0; k < 2; ++k) \
        acc[ai][bj][m][n] = __builtin_amdgcn_mfma_f32_16x16x32_bf16(Bt[n][k], At[m][k], acc[ai][bj][m][n], 0, 0, 0); __builtin_amdgcn_s_setprio(0); } while (0)
#define PG8_WAIT_V(n) asm volatile("s_waitcnt vmcnt(" #n ")" ::: "memory")
#define PG8_WAIT_L(n) asm volatile("s_waitcnt lgkmcnt(" #n ")" ::: "memory")
#define PG8_BAR __builtin_amdgcn_s_barrier()
#define PG8_SCHED __builtin_amdgcn_sched_barrier(0)
    Unit cur, nxt; int ui = 0;
    if (!S.next(0, cur)) return;
    f32x4 acc[2][2][4][2];
#pragma unroll
    for (int a = 0; a < 2; ++a)
#pragma unroll
        for (int b = 0; b < 2; ++b)
#pragma unroll
            for (int m = 0; m < 4; ++m)
#pragma unroll
                for (int n = 0; n < 2; ++n) acc[a][b][m][n] = (f32x4){0.f, 0.f, 0.f, 0.f};
    bf16x8 At[4][2], B0[2][2], B1[2][2];
    const char* cA = (const char*)g.A + (size_t)cur.pm * tstep; const char* cB = (const char*)g.Bt + (size_t)cur.pn * tstep;
    S.a_ready(cur);
    if constexpr (SP2) {
        PG8_STAGE(PG8_SB(0, 0), cB, voffB); PG8_STAGE(PG8_SB(0, 1), cB + hstepB, voffB); PG8_STAGE(PG8_SA(0, 0), cA, voffA); PG8_STAGE(PG8_SA(0, 1), cA + hstep, voffA);
        if (wr == 1) PG8_BAR;
        PG8_WAIT_V(2); PG8_BAR;
        PG8_STAGE(PG8_SB(1, 0), cB + kstep, voffB); PG8_STAGE(PG8_SA(1, 0), cA + kstep, voffA); PG8_STAGE(PG8_SB(1, 1), cB + hstepB + kstep, voffB);
        PG8_WAIT_V(6); PG8_BAR;
    } else {
        PG8_STAGE(PG8_SB(0, 0), cB, voffB); PG8_STAGE(PG8_SA(0, 0), cA, voffA); PG8_STAGE(PG8_SB(0, 1), cB + hstepB, voffB); PG8_STAGE(PG8_SA(0, 1), cA + hstep, voffA);
        if (wr == 1) PG8_BAR;
        PG8_WAIT_V(4); PG8_BAR;
        PG8_STAGE(PG8_SB(1, 0), cB + kstep, voffB); PG8_STAGE(PG8_SA(1, 0), cA + kstep, voffA); PG8_STAGE(PG8_SB(1, 1), cB + hstepB + kstep, voffB);
        PG8_WAIT_V(6); PG8_BAR;
    }
    for (;;) {
        const bool has_next = S.next(ui + 1, nxt);
        const char* nA = has_next ? (const char*)g.A + (size_t)nxt.pm * tstep : cA; const char* nB = has_next ? (const char*)g.Bt + (size_t)nxt.pn * tstep : cB;
        for (int t = 0; t < nt; t += 2) {
            const bool last = (t == nt - 2);
            const char* a1 = cA + (size_t)(t + 1) * kstep;
            const char* a2 = last ? nA : cA + (size_t)(t + 2) * kstep; const char* b2 = last ? nB : cB + (size_t)(t + 2) * kstep;
            const char* a3 = a2 + kstep; const char* b3 = b2 + kstep;
            if (last && has_next) S.a_ready(nxt);
            if constexpr (SP2) {
            PG8_LDB(B0, 0, 0); PG8_LDB(B1, 0, 1); PG8_SCHED; PG8_LDA(At, 0, 0); PG8_STAGE(PG8_SA(1, 1), a1 + hstep, voffA);
            PG8_WAIT_V(8); PG8_WAIT_L(0); PG8_BAR; PG8_MMA(0, 0, At, B0); PG8_MMA(0, 1, At, B1); PG8_BAR; PG8_SCHED;
            PG8_LDA(At, 0, 1); PG8_STAGE(PG8_SB(0, 0), b2, voffB); PG8_STAGE(PG8_SB(0, 1), b2 + hstepB, voffB); PG8_STAGE(PG8_SA(0, 0), a2, voffA);
            PG8_WAIT_V(8); PG8_WAIT_L(0); PG8_BAR; PG8_MMA(1, 0, At, B0); PG8_MMA(1, 1, At, B1); PG8_BAR; PG8_SCHED;
            PG8_LDB(B0, 1, 0); PG8_LDB(B1, 1, 1); PG8_SCHED; PG8_LDA(At, 1, 0); PG8_STAGE(PG8_SA(0, 1), a2 + hstep, voffA);
            PG8_WAIT_V(8); PG8_WAIT_L(0); PG8_BAR; PG8_MMA(0, 0, At, B0); PG8_MMA(0, 1, At, B1); PG8_BAR; PG8_SCHED;
            PG8_LDA(At, 1, 1); PG8_STAGE(PG8_SB(1, 0), b3, voffB); PG8_STAGE(PG8_SB(1, 1), b3 + hstepB, voffB); PG8_STAGE(PG8_SA(1, 0), a3, voffA);
            PG8_WAIT_V(8); PG8_WAIT_L(0); PG8_BAR; PG8_MMA(1, 0, At, B0); PG8_MMA(1, 1, At, B1); PG8_BAR; PG8_SCHED;
            } else {
            PG8_LDB(B0, 0, 0); PG8_SCHED; PG8_LDA(At, 0, 0); PG8_STAGE(PG8_SA(1, 1), a1 + hstep, voffA);
            PG8_WAIT_L(8); PG8_BAR; PG8_WAIT_L(0); PG8_MMA(0, 0, At, B0); PG8_BAR; PG8_SCHED;
            PG8_LDB(B1, 0, 1); PG8_STAGE(PG8_SB(0, 0), b2, voffB);
            PG8_BAR; PG8_WAIT_L(0); PG8_MMA(0, 1, At, B1); PG8_BAR;
            PG8_LDA(At, 0, 1); PG8_STAGE(PG8_SA(0, 0), a2, voffA);
            PG8_BAR; PG8_WAIT_L(0); PG8_MMA(1, 0, At, B0); PG8_BAR; PG8_SCHED;
            PG8_STAGE(PG8_SB(0, 1), b2 + hstepB, voffB);
            PG8_WAIT_V(6); PG8_BAR; PG8_MMA(1, 1, At, B1); PG8_BAR;
            PG8_LDB(B0, 1, 0); PG8_SCHED; PG8_LDA(At, 1, 0); PG8_STAGE(PG8_SA(0, 1), a2 + hstep, voffA);
            PG8_WAIT_L(8); PG8_BAR; PG8_WAIT_L(0); PG8_MMA(0, 0, At, B0); PG8_BAR; PG8_SCHED;
            PG8_LDB(B1, 1, 1); PG8_STAGE(PG8_SB(1, 0), b3, voffB);
            PG8_BAR; PG8_WAIT_L(0); PG8_MMA(0, 1, At, B1); PG8_BAR;
            PG8_LDA(At, 1, 1); PG8_STAGE(PG8_SA(1, 0), a3, voffA);
            PG8_BAR; PG8_WAIT_L(0); PG8_MMA(1, 0, At, B0); PG8_BAR; PG8_SCHED;
            PG8_STAGE(PG8_SB(1, 1), b3 + hstepB, voffB);
            PG8_WAIT_V(6); PG8_BAR; PG8_MMA(1, 1, At, B1); PG8_BAR;
            }
        }
        if constexpr (ALIGN_EPI) { if (wr == 0) PG8_BAR; }
        if constexpr (!Epi::AFTER_DRAIN) { E(acc, cur, wr, wc, fr, fq); S.done(cur); }
        if (!has_next) break;
#pragma unroll
        for (int a = 0; a < 2; ++a)
#pragma unroll
            for (int b = 0; b < 2; ++b)
#pragma unroll
                for (int m = 0; m < 4; ++m)
#pragma unroll
                    for (int n = 0; n < 2; ++n) acc[a][b][m][n] = (f32x4){0.f, 0.f, 0.f, 0.f};
        cur = nxt; cA = nA; cB = nB; ++ui;
        if constexpr (ALIGN_EPI) { if (wr == 1) PG8_BAR; }
    }
    PG8_WAIT_V(0);
    if constexpr (!ALIGN_EPI) { if (wr == 0) PG8_BAR; }
    PG8_BAR;
    if constexpr (Epi::AFTER_DRAIN) { E.fused(acc, cur, wr, wc, fr, fq, lds, wid, lane); S.done(cur); }
#undef PG8_SA
#undef PG8_SB
#undef PG8_STAGE
#undef PG8_LDA
#undef PG8_LDB
#undef PG8_MMA
#undef PG8_WAIT_V
#undef PG8_WAIT_L
#undef PG8_BAR
#undef PG8_SCHED
}
}
#define PG8_SP2 true
#define PG8_ALIGN true
#include <hip/hip_bf16.h>
#include <cmath>
namespace attn_body {
using bf16=__hip_bfloat16;
using bf16x8=__attribute__((ext_vector_type(8)))short;
using s16x4=__attribute__((ext_vector_type(4)))short;
using f32x16=__attribute__((ext_vector_type(16)))float;
using u32x4=__attribute__((ext_vector_type(4)))unsigned;
constexpr int BATCH=8,NHEAD=16,SEQ=4096,D=64,DM=NHEAD*D;
constexpr int NW=8,QBLK=32,QB=QBLK*NW,KVBLK=64,NQB=SEQ/QB;
constexpr int ATTN_PITCH=DM, ATTN_UNIT_ROWS=QB;
__device__ __forceinline__ int crow(int r,int hi){return (r&3)+8*(r>>2)+4*hi;}
#define SBAR() __builtin_amdgcn_sched_barrier(0)
__device__ __forceinline__ void cmask(f32x16&p0,f32x16&p1,int jb,int qrel,int hi){
  const float NEG=-INFINITY; int kb=64*jb+4*hi;
  #pragma unroll
  for(int r=0;r<16;++r){int kv=kb+(r&3)+8*(r>>2); if(kv>qrel)p0[r]=NEG; if(kv+32>qrel)p1[r]=NEG;}
}

constexpr int NSLOT=3, SLOTB=8192;
constexpr int LDS_K=0, LDS_V=NSLOT*SLOTB, LDS_WS=2*NSLOT*SLOTB, LDS_OST=LDS_WS+NW*64*4, LDS_KB=LDS_OST+NW*4096, LDS_BYTES=LDS_KB+SEQ*4;
constexpr float C2=0.125f*1.4426950408889634f;
__device__ __forceinline__ void glds16(const void*gsrc,unsigned lds_dst){unsigned keep;
  asm volatile("s_mov_b32 %0, m0\n\ts_mov_b32 m0, %2\n\ts_nop 0\n\tglobal_load_lds_dwordx4 %1, off\n\ts_mov_b32 m0, %0":"=&s"(keep):"v"(gsrc),"s"(lds_dst):"memory");}
__device__ __forceinline__ float max3f(float a,float b,float c){float r;asm("v_max3_f32 %0, %1, %2, %3":"=v"(r):"v"(a),"v"(b),"v"(c));return r;}
__device__ __forceinline__ float max2f(float a,float b){float r;asm("v_max_f32_e32 %0, %1, %2":"=v"(r):"v"(a),"v"(b));return r;}
__device__ __forceinline__ float fadd_s(float a,float b){float r;asm("v_add_f32_e32 %0, %1, %2":"=v"(r):"v"(a),"v"(b));return r;}
__device__ __forceinline__ float fsub_s(float a,float b){float r;asm("v_sub_f32_e32 %0, %1, %2":"=v"(r):"v"(a),"v"(b));return r;}
typedef float f32x2_t __attribute__((ext_vector_type(2))); typedef __bf16 bf16x2_t __attribute__((ext_vector_type(2)));
__device__ __forceinline__ unsigned cvtpk_s(float lo,float hi){f32x2_t v={lo,hi};bf16x2_t b=__builtin_convertvector(v,bf16x2_t);return __builtin_bit_cast(unsigned,b);}
#define WAIT_BAR(N) asm volatile("s_waitcnt vmcnt(" #N ") lgkmcnt(0)\n\ts_barrier":::"memory")

__device__ __forceinline__ void qkt(f32x16&p0,f32x16&p1,const char*Kslot,const bf16x8*qr,const f32x16&negm,int r32,int hi){
  const char*kb=Kslot+hi*1024+r32*16;
  #pragma unroll
  for(int d0=0;d0<4;++d0){
    const bf16x8 b0=*reinterpret_cast<const bf16x8*>(kb+d0*2048);
    const bf16x8 b1=*reinterpret_cast<const bf16x8*>(kb+d0*2048+512);
    if(d0==0){p0=__builtin_amdgcn_mfma_f32_32x32x16_bf16(b0,qr[0],negm,0,0,0);p1=__builtin_amdgcn_mfma_f32_32x32x16_bf16(b1,qr[0],negm,0,0,0);}
    else{p0=__builtin_amdgcn_mfma_f32_32x32x16_bf16(b0,qr[d0],p0,0,0,0);p1=__builtin_amdgcn_mfma_f32_32x32x16_bf16(b1,qr[d0],p1,0,0,0);}}
}
typedef __attribute__((address_space(3))) const char* lds_cptr;
typedef short v4i16_t __attribute__((ext_vector_type(4)));
__device__ __forceinline__ void kload8(bf16x8*kf,lds_cptr kp){
  kf[0]=*(const __attribute__((address_space(3))) bf16x8*)(kp);      kf[1]=*(const __attribute__((address_space(3))) bf16x8*)(kp+512);
  kf[2]=*(const __attribute__((address_space(3))) bf16x8*)(kp+2048); kf[3]=*(const __attribute__((address_space(3))) bf16x8*)(kp+2560);
  kf[4]=*(const __attribute__((address_space(3))) bf16x8*)(kp+4096); kf[5]=*(const __attribute__((address_space(3))) bf16x8*)(kp+4608);
  kf[6]=*(const __attribute__((address_space(3))) bf16x8*)(kp+6144); kf[7]=*(const __attribute__((address_space(3))) bf16x8*)(kp+6656);
}
__device__ __forceinline__ void kload2(bf16x8*kf,lds_cptr kp,int j){ kf[2*j]=*(const __attribute__((address_space(3))) bf16x8*)(kp+j*2048); kf[2*j+1]=*(const __attribute__((address_space(3))) bf16x8*)(kp+j*2048+512); }
__device__ __forceinline__ s16x4 vtr(lds_cptr p){ return __builtin_bit_cast(s16x4,__builtin_amdgcn_ds_read_tr16_b64_v4i16((__attribute__((address_space(3))) v4i16_t*)p)); }
__device__ __forceinline__ float rowmax(const f32x16&p0,const f32x16&p1){
  float a=max3f(p0[0],p0[1],p1[0]),b=max3f(p0[2],p0[3],p1[1]);a=max3f(a,p1[2],p1[3]);
  #pragma unroll
  for(int r=4;r<16;r+=4){a=max3f(a,p0[r],p0[r+1]);b=max3f(b,p0[r+2],p0[r+3]);a=max3f(a,p1[r],p1[r+1]);b=max3f(b,p1[r+2],p1[r+3]);}
  const float m=max2f(a,b);
  auto rr=__builtin_amdgcn_permlane32_swap(__float_as_uint(m),__float_as_uint(m),false,false);
  return max2f(__uint_as_float(rr[0]),__uint_as_float(rr[1]));
}
__device__ __forceinline__ void pv(f32x16*o,int vb,bf16x8 pa0,bf16x8 pa1,bf16x8 pa2,bf16x8 pa3){
  #pragma unroll
  for(int d0=0;d0<2;++d0){s16x4 lo[4],hi[4];
    #pragma unroll
    for(int ks=0;ks<4;++ks){
      asm volatile("ds_read_b64_tr_b16 %0,%1 offset:%c2":"=&v"(lo[ks]):"v"(vb),"i"(d0*4096+ks*1024):"memory");
      asm volatile("ds_read_b64_tr_b16 %0,%1 offset:%c2":"=&v"(hi[ks]):"v"(vb),"i"(d0*4096+ks*1024+512):"memory");}
    asm volatile("s_waitcnt lgkmcnt(0)":::"memory");SBAR();
    #define PK(k) (bf16x8){lo[k][0],lo[k][1],lo[k][2],lo[k][3],hi[k][0],hi[k][1],hi[k][2],hi[k][3]}
    o[d0]=__builtin_amdgcn_mfma_f32_32x32x16_bf16(pa0,PK(0),o[d0],0,0,0);
    o[d0]=__builtin_amdgcn_mfma_f32_32x32x16_bf16(pa1,PK(1),o[d0],0,0,0);
    o[d0]=__builtin_amdgcn_mfma_f32_32x32x16_bf16(pa2,PK(2),o[d0],0,0,0);
    o[d0]=__builtin_amdgcn_mfma_f32_32x32x16_bf16(pa3,PK(3),o[d0],0,0,0);
    #undef PK
  }
}

#ifndef ATTN_STORE16
#define ATTN_STORE16(p,v) (*(u32x4*)(p)=(v))
#endif
typedef float f32x4_t __attribute__((ext_vector_type(4)));
__device__ __forceinline__ float bflo(unsigned v){return __uint_as_float(v<<16);} __device__ __forceinline__ float bfhi(unsigned v){return __uint_as_float(v&0xffff0000u);}
__device__ __forceinline__ unsigned gate2(unsigned ov,unsigned gv){ const float g0=bflo(gv),g1=bfhi(gv); const float s0=__builtin_amdgcn_rcpf(1.f+__builtin_amdgcn_exp2f(-1.4426950408889634f*g0)),s1=__builtin_amdgcn_rcpf(1.f+__builtin_amdgcn_exp2f(-1.4426950408889634f*g1)); return cvtpk_s(bflo(ov)*s0,bfhi(ov)*s1); }
template<int THRL> __device__ __forceinline__ void attn_unit(int b,int h,int qb,const bf16*Q,const bf16*__restrict__ K,const bf16*__restrict__ V,bf16*O,const bf16*__restrict__ Gt,const float*__restrict__ KBg,char*shm){
  int tid_a_=threadIdx.x; asm volatile("":"+v"(tid_a_)); const int tid=tid_a_,lane=tid&63,r32=lane&31,hi=lane>>5; const int wid=__builtin_amdgcn_readfirstlane(tid>>6);
  const long rowbase=(long)b*SEQ; const int q0=qb*QB;
  const bf16*Qw=Q+(rowbase+q0+wid*QBLK)*DM+h*D;
  const bf16*Kh=K+rowbase*DM+h*D,*Vh=V+rowbase*DM+h*D;
  const unsigned lds0=(unsigned)(uintptr_t)shm;
  float*wsf=(float*)(shm+LDS_WS)+wid*64;
  const bf16*ksrc=Kh+(long)lane*DM+wid*8;
  const bf16*vsrc=Vh+(long)(16*(wid&3)+(lane>>2))*DM+(wid>>2)*32+(lane&3)*8;
  const unsigned kdst=lds0+LDS_K+wid*1024, vdst=lds0+LDS_V+wid*1024;
  #define DMA_K(t,slot) glds16(ksrc+(long)(t)*KVBLK*DM,(unsigned)__builtin_amdgcn_readfirstlane(kdst+(slot)))
  #define DMA_V(t,slot) glds16(vsrc+(long)(t)*KVBLK*DM,(unsigned)__builtin_amdgcn_readfirstlane(vdst+(slot)))
  const int vb0=(int)(lds0+LDS_V)+((lane>>4)&1)*32+(lane&3)*8+(4*hi+((lane&15)>>2))*64;
  const char*Kbase=shm+LDS_K; bf16x8 kf[8];
  const lds_cptr shm3=(lds_cptr)shm; const lds_cptr kp0=shm3+LDS_K+hi*1024+r32*16; const lds_cptr vp0=shm3+LDS_V+((lane>>4)&1)*32+(lane&3)*8+(4*hi+((lane&15)>>2))*64;
  { const u32x4*src_=(const u32x4*)(KBg+((long)b*NHEAD+h)*SEQ); __attribute__((address_space(3))) u32x4*dst_=(__attribute__((address_space(3))) u32x4*)(shm3+LDS_KB);
    for(int i_=tid;i_<(q0+QB)/4;i_+=NW*64)dst_[i_]=src_[i_]; }
  #define KBIAS(P0,P1,t) do{ const __attribute__((address_space(3))) f32x4_t*kp_=(const __attribute__((address_space(3))) f32x4_t*)(shm3+LDS_KB+(t)*256+hi*16); \
    _Pragma("unroll") for(int g_=0;g_<4;++g_){ const f32x4_t b0_=kp_[2*g_],b1_=kp_[8+2*g_]; \
      P0[4*g_]+=b0_[0];P0[4*g_+1]+=b0_[1];P0[4*g_+2]+=b0_[2];P0[4*g_+3]+=b0_[3]; P1[4*g_]+=b1_[0];P1[4*g_+1]+=b1_[1];P1[4*g_+2]+=b1_[2];P1[4*g_+3]+=b1_[3]; } }while(0)
  const int NT=(q0+QB)/KVBLK;
  DMA_K(0,0);DMA_V(0,0);DMA_K(1,SLOTB);
  bf16x8 qr[4];
  #pragma unroll
  for(int d0=0;d0<4;++d0)qr[d0]=*reinterpret_cast<const bf16x8*>(&Qw[(long)r32*DM+d0*16+hi*8]);
  float mhat=0.f,l_reg=0.f;f32x16 o[2];o[0]=f32x16{};o[1]=f32x16{};f32x16 negm=f32x16{};asm volatile("":"+v"(negm));
  const int qrel=wid*QBLK+r32;
  #define CMASK(P0,P1,t) do{int jb_=(t)-(NT-4); if(jb_>=0)cmask(P0,P1,jb_,qrel,hi);}while(0)
  bool resc=false;
  #define START(P0,P1) do{ const float rm=rowmax(P0,P1); resc=false; \
    { const float dl=rm; mhat=fadd_s(mhat,dl); \
      _Pragma("unroll") for(int r=0;r<16;++r){P0[r]=fsub_s(P0[r],dl);P1[r]=fsub_s(P1[r],dl);} \
      _Pragma("unroll") for(int r=0;r<16;++r)negm[r]=-mhat; asm volatile("":"+v"(negm)); } \
    _Pragma("unroll") for(int r=0;r<16;++r)P0[r]=__builtin_amdgcn_exp2f(P0[r]); }while(0)
  #define RESC() do{ if(resc){ asm volatile("s_waitcnt lgkmcnt(0)":::"memory"); \
      _Pragma("unroll") for(int d_=0;d_<2;++d_) _Pragma("unroll") for(int r=0;r<16;++r)o[d_][r]*=wsf[crow(r,hi)]; } }while(0)
  f32x16 pA0,pA1,pB0,pB1;
  int sl_prev=0,sl_cur=0,sl_next=SLOTB;
  #define ROT() do{sl_prev=sl_cur;sl_cur=sl_next;sl_next=(sl_next==(NSLOT-1)*SLOTB)?0:sl_next+SLOTB;}while(0)
  DMA_K(2,2*SLOTB);
  WAIT_BAR(3);
  qkt(pA0,pA1,Kbase,qr,negm,r32,hi);asm volatile("s_nop 15\n\ts_nop 7":"+v"(pA0),"+v"(pA1));KBIAS(pA0,pA1,0);CMASK(pA0,pA1,0);
  START(pA0,pA1);
  _Pragma("unroll") for(int r=0;r<16;++r)pA1[r]=__builtin_amdgcn_exp2f(pA1[r]);
  WAIT_BAR(0);
  DMA_K(3,0);DMA_V(1,SLOTB);
  ROT();
  kload8(kf,kp0+sl_cur);
  WAIT_BAR(2);
  s16x4 vlo[8],vhi[8]; u32x4 pw0,pw1,pw2,pw3;
  #define PKW(P,B) cvtpk_s(P[B],P[B+1])
  #define PAF(k) __builtin_bit_cast(bf16x8,pw##k)
  #define VFR(i) (bf16x8){vlo[i][0],vlo[i][1],vlo[i][2],vlo[i][3],vhi[i][0],vhi[i][1],vhi[i][2],vhi[i][3]}
  #define PIN(x) asm volatile("":"+v"(x))
  #define MX3(a,b,c) __builtin_fmaxf(__builtin_fmaxf((a),(b)),(c))
  #define GAPA(MF,A0,A1,A2,A3,W0,W1,PW) do{ MF; sacc+=A0; sacc+=A1; sacc+=A2; sacc+=A3; PIN(sacc); W0; W1; PIN(PW); SBAR(); }while(0)
  #define EX(v) __builtin_amdgcn_exp2f(v)
  #define GAPB(MF,X,B) do{ MF; X[B]=EX(X[B]); X[B+1]=EX(X[B+1]); X[B+2]=EX(X[B+2]); X[B+3]=EX(X[B+3]); PIN(X); SBAR(); }while(0)
  #define VRD(i) do{ vlo[i]=vtr(vp_+(((i)>>2)*4096+((i)&3)*1024)); vhi[i]=vtr(vp_+(((i)>>2)*4096+((i)&3)*1024+512)); }while(0)
  #define KRD(G,j) do{ if(G){ kload2(kf,kp0+sl_next,j); SBAR(); } }while(0)
  #define STEP(C0,C1,P0,P1,t,GK,GV,GL) do{ SBAR(); \
    const lds_cptr vp_=vp0+sl_prev; \
    VRD(0); SBAR(); float sacc=(P0[0]+P0[1]); \
    GAPA(C0=__builtin_amdgcn_mfma_f32_32x32x16_bf16(kf[0],qr[0],negm,0,0,0), P0[2],P0[3],P0[4],P0[5],     pw0[0]=PKW(P0,0), pw0[1]=PKW(P0,2), pw0); \
    VRD(4); SBAR(); GAPA(C1=__builtin_amdgcn_mfma_f32_32x32x16_bf16(kf[1],qr[0],negm,0,0,0), P0[6],P0[7],P0[8],P0[9],     pw0[2]=PKW(P0,4), pw0[3]=PKW(P0,6), pw0); \
    VRD(1); SBAR(); GAPA(C0=__builtin_amdgcn_mfma_f32_32x32x16_bf16(kf[2],qr[1],C0,0,0,0),   P0[10],P0[11],P0[12],P0[13], pw1[0]=PKW(P0,8), pw1[1]=PKW(P0,10), pw1); \
    VRD(5); SBAR(); GAPA(C1=__builtin_amdgcn_mfma_f32_32x32x16_bf16(kf[3],qr[1],C1,0,0,0),   P0[14],P0[15],P1[0],P1[1],   pw1[2]=PKW(P0,12),pw1[3]=PKW(P0,14), pw1); \
    VRD(2); SBAR(); GAPA(C0=__builtin_amdgcn_mfma_f32_32x32x16_bf16(kf[4],qr[2],C0,0,0,0),   P1[2],P1[3],P1[4],P1[5],     pw2[0]=PKW(P1,0), pw2[1]=PKW(P1,2), pw2); \
    VRD(6); SBAR(); GAPA(C1=__builtin_amdgcn_mfma_f32_32x32x16_bf16(kf[5],qr[2],C1,0,0,0),   P1[6],P1[7],P1[8],P1[9],     pw2[2]=PKW(P1,4), pw2[3]=PKW(P1,6), pw2); \
    VRD(3); SBAR(); GAPA(C0=__builtin_amdgcn_mfma_f32_32x32x16_bf16(kf[6],qr[3],C0,0,0,0),   P1[10],P1[11],P1[12],P1[13], pw3[0]=PKW(P1,8), pw3[1]=PKW(P1,10), pw3); \
    VRD(7); SBAR(); GAPA(C1=__builtin_amdgcn_mfma_f32_32x32x16_bf16(kf[7],qr[3],C1,0,0,0),   P1[14],P1[15],0.f,0.f,       pw3[2]=PKW(P1,12),pw3[3]=PKW(P1,14), pw3); \
    l_reg+=sacc; \
    if(GK){DMA_K((t)+3,sl_cur);} if(GV){DMA_V((t)+1,sl_next);} \
    KBIAS(C0,C1,t); CMASK(C0,C1,t); \
    { float a=MX3(C0[0],C0[1],C1[0]),b=MX3(C0[2],C0[3],C1[1]); a=MX3(a,C1[2],C1[3]); \
      _Pragma("unroll") for(int r=4;r<16;r+=4){a=MX3(a,C0[r],C0[r+1]);b=MX3(b,C0[r+2],C0[r+3]);a=MX3(a,C1[r],C1[r+1]);b=MX3(b,C1[r+2],C1[r+3]);} \
      float rm=__builtin_fmaxf(a,b); { auto rr=__builtin_amdgcn_permlane32_swap(__float_as_uint(rm),__float_as_uint(rm),false,false); rm=__builtin_fmaxf(__uint_as_float(rr[0]),__uint_as_float(rr[1])); } \
      resc=false; \
      if(__builtin_expect(__any(rm>(float)THRL),0)){ const float dl=__builtin_fmaxf(rm,0.f); mhat+=dl; \
        _Pragma("unroll") for(int r=0;r<16;++r){C0[r]-=dl;C1[r]-=dl;} \
        _Pragma("unroll") for(int r=0;r<16;++r)negm[r]=-mhat; asm volatile("":"+v"(negm)); \
        const float f=__builtin_amdgcn_exp2f(-dl); l_reg*=f; if(hi==0)wsf[r32]=f; resc=true; } } \
    SBAR(); \
    GAPB(o[0]=__builtin_amdgcn_mfma_f32_32x32x16_bf16(PAF(0),VFR(0),o[0],0,0,0), C0,0); \
    GAPB(o[1]=__builtin_amdgcn_mfma_f32_32x32x16_bf16(PAF(0),VFR(4),o[1],0,0,0), C0,4); \
    KRD(GL,0); GAPB(o[0]=__builtin_amdgcn_mfma_f32_32x32x16_bf16(PAF(1),VFR(1),o[0],0,0,0), C0,8); \
    KRD(GL,1); GAPB(o[1]=__builtin_amdgcn_mfma_f32_32x32x16_bf16(PAF(1),VFR(5),o[1],0,0,0), C0,12); \
    KRD(GL,2); GAPB(o[0]=__builtin_amdgcn_mfma_f32_32x32x16_bf16(PAF(2),VFR(2),o[0],0,0,0), C1,0); \
    KRD(GL,3); GAPB(o[1]=__builtin_amdgcn_mfma_f32_32x32x16_bf16(PAF(2),VFR(6),o[1],0,0,0), C1,4); \
    GAPB(o[0]=__builtin_amdgcn_mfma_f32_32x32x16_bf16(PAF(3),VFR(3),o[0],0,0,0), C1,8); \
    GAPB(o[1]=__builtin_amdgcn_mfma_f32_32x32x16_bf16(PAF(3),VFR(7),o[1],0,0,0), C1,12); \
    }while(0)
  int t=1;
  #undef CMASK
  #define CMASK(P0,P1,t) do{}while(0)
  for(;t+5<NT;t+=2){
    STEP(pB0,pB1,pA0,pA1,t,true,true,true);     WAIT_BAR(2); RESC(); ROT();
    STEP(pA0,pA1,pB0,pB1,t+1,true,true,true);   WAIT_BAR(2); RESC(); ROT();
  }
  #undef CMASK
  #define CMASK(P0,P1,t) do{int jb_=(t)-(NT-4); if(jb_>=0)cmask(P0,P1,jb_,qrel,hi);}while(0)
  #define ENDW(tt) do{ if((tt)+3<NT){WAIT_BAR(2);} else if((tt)+2<NT){WAIT_BAR(1);} else {WAIT_BAR(0);} }while(0)
  for(;t+1<NT;t+=2){
    STEP(pB0,pB1,pA0,pA1,t,(t+3<NT),(t+1<NT),(t+1<NT));       ENDW(t);   RESC(); ROT();
    STEP(pA0,pA1,pB0,pB1,t+1,(t+4<NT),(t+2<NT),(t+2<NT));     ENDW(t+1); RESC(); ROT();
  }
  STEP(pB0,pB1,pA0,pA1,NT-1,false,false,false); RESC();
  { float sacc=pB0[0]+pB0[1]; _Pragma("unroll") for(int r=2;r<16;++r)sacc+=pB0[r]; _Pragma("unroll") for(int r=0;r<16;++r)sacc+=pB1[r]; l_reg+=sacc;
    pw0=(u32x4){PKW(pB0,0),PKW(pB0,2),PKW(pB0,4),PKW(pB0,6)};pw1=(u32x4){PKW(pB0,8),PKW(pB0,10),PKW(pB0,12),PKW(pB0,14)};pw2=(u32x4){PKW(pB1,0),PKW(pB1,2),PKW(pB1,4),PKW(pB1,6)};pw3=(u32x4){PKW(pB1,8),PKW(pB1,10),PKW(pB1,12),PKW(pB1,14)};
    SBAR(); pv(o,vb0+sl_cur,PAF(0),PAF(1),PAF(2),PAF(3)); }
  #undef PKW
  #undef PAF
  #undef VFR
  #undef PIN
  #undef MX3
  #undef GAPA
  #undef GAPB
  #undef EX
  #undef VRD
  #undef KRD
  #undef STEP
  #undef ENDW
  {auto rr=__builtin_amdgcn_permlane32_swap(__float_as_uint(l_reg),__float_as_uint(l_reg),false,false);l_reg=__uint_as_float(rr[0])+__uint_as_float(rr[1]);}
  if(hi==0)wsf[32+r32]=l_reg;asm volatile("s_waitcnt lgkmcnt(0)":::"memory");
  float rli[16];
  #pragma unroll
  for(int r=0;r<16;++r)rli[r]=__builtin_amdgcn_rcpf(wsf[32+crow(r,hi)]);
  bf16*Ow=O+(rowbase+q0+wid*QBLK)*DM+h*D; const bf16*Gw=Gt+(rowbase+q0+wid*QBLK)*DM+h*D;
  { bf16*stg=(bf16*)(shm+LDS_OST)+wid*2048;
    #pragma unroll
    for(int r=0;r<16;++r){const int orow=crow(r,hi);
      #pragma unroll
      for(int d0=0;d0<2;++d0)stg[orow*64+d0*32+r32]=__float2bfloat16(o[d0][r]*rli[r]);}
    asm volatile("s_waitcnt lgkmcnt(0)":::"memory");
    #pragma unroll
    for(int i=0;i<4;++i){const int row=i*8+(lane>>3),ch=lane&7; u32x4 v=*(const u32x4*)(stg+row*64+ch*8); const u32x4 gv=*(const u32x4*)(Gw+(long)row*DM+ch*8); v.x=gate2(v.x,gv.x);v.y=gate2(v.y,gv.y);v.z=gate2(v.z,gv.z);v.w=gate2(v.w,gv.w); ATTN_STORE16(Ow+(long)row*DM+ch*8,v);} }
  asm volatile("s_waitcnt lgkmcnt(0)\n\ts_barrier":::"memory");
  #undef KBIAS
  #undef DMA_K
  #undef DMA_V
  #undef CMASK
  #undef START
  #undef RESC
  #undef ROT
}
constexpr int ATTN_LDS_BYTES=LDS_BYTES;
struct AttnTensors { const bf16* Q; const bf16* K; const bf16* V; bf16* O; const bf16* G; const float* KB; };
struct AttnUnit { int bh; int qb; };
struct StaticOrder {
  int vcu;
  int G_;
  __device__ __forceinline__ explicit StaticOrder(int grid,int block):vcu((grid%8==0)?(block%8)*(grid/8)+block/8:block),G_(grid){}
  __device__ __forceinline__ bool next(int i,AttnUnit&u)const{ const int pu=vcu+(i>>1)*G_; if(pu>=BATCH*NHEAD*(NQB/2))return false; const int s=pu%(NQB/2); u.bh=pu/(NQB/2); u.qb=(i&1)?(NQB-1-s):s; return true; }
  __device__ __forceinline__ void a_ready(const AttnUnit&)const{}
  __device__ __forceinline__ void done(const AttnUnit&)const{}
};
template<class Sched,int THRL=8> __device__ __forceinline__ void attn_phase(char*lds,const AttnTensors&T,const Sched&S){
  AttnUnit u;
  for(int i=0;S.next(i,u);++i){ S.a_ready(u); attn_unit<THRL>(u.bh/NHEAD,u.bh%NHEAD,u.qb,T.Q,T.K,T.V,T.O,T.G,T.KB,lds); S.done(u); }
}
#undef SBAR
#undef WAIT_BAR
}
#define GAS __attribute__((address_space(1)))
#define LAS __attribute__((address_space(3)))
typedef unsigned short bf16;
typedef unsigned v4u __attribute__((ext_vector_type(4)));
typedef float f32x4 __attribute__((ext_vector_type(4)));
typedef short bf16x8 __attribute__((ext_vector_type(8)));
typedef GAS unsigned gu32;
typedef GAS unsigned long long gu64;
#define RLX_AGENT __ATOMIC_RELAXED, __HIP_MEMORY_SCOPE_AGENT
#define LDS_WAIT() asm volatile("s_waitcnt lgkmcnt(0)" ::: "memory")
#define VM_WAIT() asm volatile("s_waitcnt vmcnt(0)" ::: "memory")
__device__ __forceinline__ unsigned long long rt() { return __builtin_amdgcn_s_memrealtime(); }
__device__ __forceinline__ unsigned f2bf(float f) { unsigned u = __builtin_bit_cast(unsigned, f); return (u + 0x7fffu + ((u >> 16) & 1u)) >> 16; }
__device__ __forceinline__ unsigned pk2(float lo, float hi) { return f2bf(lo) | (f2bf(hi) << 16); }

#define XB_TMO      128
#define XB_XCNT(j)  (256  + 64 * (j))
#define XB_XSUB(j)  (1280 + 64 * (j))
#define XB_XGEN(j)  (2304 + 64 * (j))
#define XB_TOP      3328
#define XB_TOPGEN   3392
#define XCD_BAR_WORDS 3456
#define XB_SPIN_CAP (1u << 18)

__device__ __forceinline__ unsigned xb_ld(unsigned* p)              { return __hip_atomic_load(p, __ATOMIC_RELAXED, __HIP_MEMORY_SCOPE_AGENT); }
__device__ __forceinline__ unsigned xb_add(unsigned* p, unsigned v) { return __hip_atomic_fetch_add(p, v, __ATOMIC_RELAXED, __HIP_MEMORY_SCOPE_AGENT); }
__device__ __forceinline__ unsigned xb_xcc_id() { return (unsigned)__builtin_amdgcn_s_getreg((3 << 11) | 20) & 0xFu; }
#define XB_SPIN(cond, bar) do { unsigned _sp = 0; while (cond) { __builtin_amdgcn_s_sleep(1); \
    if ((++_sp & 255u) == 0u) { if (xb_ld(&(bar)[XB_TMO])) break; if (_sp > XB_SPIN_CAP) { atomicAdd(&(bar)[XB_TMO], 1u); break; } } } } while (0)

struct XcdBarrier {
    unsigned* bar; unsigned x;
    volatile LAS unsigned* st;
};

__device__ __forceinline__ XcdBarrier xcd_barrier_post(unsigned* bar, volatile LAS unsigned* st) {
    XcdBarrier b; b.bar = bar; b.x = xb_xcc_id(); b.st = st;
    if (threadIdx.x == 0) (void)xb_add(&bar[XB_XCNT(b.x)], 1u);
    return b;
}
__device__ __forceinline__ void xcd_barrier_complete(unsigned* bar, unsigned x, unsigned& nloc, unsigned& nx) {
    const unsigned G = gridDim.x * gridDim.y * gridDim.z;
    unsigned sum, cnt, mine, sp = 0u;
    for (;;) {
        sum = 0u; cnt = 0u; mine = 0u;
#pragma unroll
        for (unsigned j = 0; j < 16; ++j) { const unsigned c = xb_ld(&bar[XB_XCNT(j)]); sum += c; cnt += (c > 0u) ? 1u : 0u; mine = (j == x) ? c : mine; }
        if (sum == G) break;
        __builtin_amdgcn_s_sleep(1);
        if ((++sp & 255u) == 0u) { if (xb_ld(&bar[XB_TMO])) break; if (sp > XB_SPIN_CAP) { atomicAdd(&bar[XB_TMO], 1u); break; } }
    }
    nloc = mine > 0u ? mine : 1u; nx = cnt > 0u ? cnt : 1u;
}

__device__ __forceinline__ void xcd_barrier(const XcdBarrier& b) {
    asm volatile("s_waitcnt vmcnt(0)" ::: "memory");
    __syncthreads();
    if (threadIdx.x == 0) {
        unsigned* bar = b.bar;
        __builtin_amdgcn_s_waitcnt(0);
        unsigned nloc = b.st[0], nx = b.st[1];
        if (nloc == 0u) { xcd_barrier_complete(bar, b.x, nloc, nx); b.st[0] = nloc; b.st[1] = nx; }
        const unsigned old = xb_add(&bar[XB_XSUB(b.x)], 1u);
        const unsigned gen = old / nloc;
        if (old + 1u == (gen + 1u) * nloc) {
            __builtin_amdgcn_fence(__ATOMIC_RELEASE, "agent");
            asm volatile("s_waitcnt vmcnt(0)" ::: "memory");
            const unsigned og = xb_add(&bar[XB_TOP], 1u);
            const unsigned tg = og / nx;
            if (og + 1u == (tg + 1u) * nx) xb_add(&bar[XB_TOPGEN], 1u);
            else XB_SPIN(xb_ld(&bar[XB_TOPGEN]) == tg, bar);
            __builtin_amdgcn_fence(__ATOMIC_ACQUIRE, "agent");
            xb_add(&bar[XB_XGEN(b.x)], 1u);
            asm volatile("s_waitcnt vmcnt(0)" ::: "memory");
        } else {
            XB_SPIN(xb_ld(&bar[XB_XGEN(b.x)]) == gen, bar);
            __builtin_amdgcn_fence(__ATOMIC_ACQUIRE, "agent");
            asm volatile("s_waitcnt vmcnt(0)" ::: "memory");
        }
    }
    __syncthreads();
}
namespace cg = cooperative_groups;
constexpr int NWAVES = 8;
constexpr int BATCH = 8, SEQ = 4096, D = 1024, FF = 4096, M = BATCH * SEQ;
constexpr int N0 = 2816;
constexpr int N1 = 4352;
constexpr int EVEN_IN = 2576, ODD_IN = 4112;
constexpr float LN_EPS = 1e-5f;
constexpr size_t MiB = 1u << 20;
constexpr size_t WS_CTL = 0, CTL_ZERO_BYTES = 1 * MiB;
constexpr size_t WS_MOD = 1 * MiB, WS_BIAS0 = 1 * MiB + 512 * 1024;
constexpr size_t WS_WIN0 = 2 * MiB, WS_WOUT0 = 8 * MiB, WS_W1_0 = 10 * MiB, WS_W2_0 = 18 * MiB, WS_WIN1 = 26 * MiB, WS_WOUT1 = 35 * MiB, WS_W1_1 = 37 * MiB, WS_W2_1 = 45 * MiB;
constexpr size_t WS_RGP = 54 * MiB, WS_RGH = 56 * MiB, WS_RGC = 58 * MiB, WS_GDEC = 60 * MiB, WS_FL = 61 * MiB, WS_KB = 63 * MiB;
constexpr size_t WS_U = 66 * MiB, WS_MIX = 130 * MiB, WS_PROJ = 194 * MiB, WS_GKV = 370 * MiB, WS_END = 450 * MiB;
constexpr size_t QKVG_STRIDE = 64 * MiB / 2;
constexpr int CW_BAR = 4096;
constexpr int RING_BYTES = 131072, LDSCTL_OFF = RING_BYTES, MISC_OFF = LDSCTL_OFF + 320, LDS_BYTES = 147456;
static_assert(attn_body::ATTN_LDS_BYTES <= RING_BYTES, "attention LDS");

struct Frame {
    LAS unsigned char* lds; volatile LAS unsigned* MISC; gu32* ctl;
    int vcu, G;
    unsigned char* ws;
};
__device__ __forceinline__ const float* inp(int i) { const __attribute__((address_space(4))) unsigned long long* k = (const __attribute__((address_space(4))) unsigned long long*)__builtin_amdgcn_kernarg_segment_ptr(); asm volatile("" : "+s"(k)); return (const float*)(const __attribute__((address_space(1))) float*)k[i]; }
#define WSP(T, off) ((T*)(F.ws + (off)))
#define PHASE_IDS int tid_ = threadIdx.x; asm volatile("" : "+v"(tid_)); const int tid = tid_, lane = tid & 63, wave = __builtin_amdgcn_readfirstlane(tid >> 6); (void)lane; (void)wave;
__device__ __forceinline__ float bf2f(bf16 v) { return __uint_as_float((unsigned)v << 16); }
__device__ __forceinline__ float sigmoid_f(float x) { return 1.f / (1.f + __expf(-x)); }
__device__ __forceinline__ float logsigmoid_f(float x) { return fminf(x, 0.f) - log1pf(expf(-fabsf(x))); }
__device__ __forceinline__ float gelu_tanh_f(float x) { return 0.5f * x * (1.f + tanhf(0.7978845608028654f * (x + 0.044715f * x * x * x))); }
__device__ __forceinline__ float wave_sum(float v) {
#pragma unroll
    for (int o = 1; o < 64; o <<= 1) v += __shfl_xor(v, o);
    return v;
}
__device__ __forceinline__ void p0_write_tile(bf16* WT, int K, int row0, int k0, LAS float* scr, int lane) {
    const int c = lane & 7;
#pragma unroll
    for (int j = 0; j < 4; ++j) { const int n = (lane >> 3) + 8 * j; const LAS float* s = scr + (8 * c) * 33 + n;
        v4u o; o.x = pk2(s[0 * 33], s[1 * 33]); o.y = pk2(s[2 * 33], s[3 * 33]); o.z = pk2(s[4 * 33], s[5 * 33]); o.w = pk2(s[6 * 33], s[7 * 33]);
        *(GAS v4u*)(WT + (size_t)(row0 + n) * K + k0 + 8 * c) = o; }
    LDS_WAIT(); asm volatile("" ::: "memory");
}
__device__ __forceinline__ void p0_transpose_item(const float* W, int ldw, int ncols, int K, int nblk, bf16* WT, int row_off, LAS float* scr, int item, int lane) {
    const int kb = item / nblk, nb = item % nblk, k0 = 64 * kb, n0 = 32 * nb; const int n = n0 + (lane & 31);
#pragma unroll 8
    for (int i = 0; i < 32; ++i) { const int kk = 2 * i + (lane >> 5); scr[kk * 33 + (lane & 31)] = (n < ncols) ? W[(size_t)(k0 + kk) * ldw + n] : 0.f; }
    LDS_WAIT(); asm volatile("" ::: "memory");
    p0_write_tile(WT, K, row_off + n0, k0, scr, lane);
}
__device__ __forceinline__ void p0_zup_item(const float* Win, const float* wup, bf16* WT, LAS float* scr, int item, int lane) {
    const int kb = item >> 3, jb = item & 7, k = 64 * kb + lane;
    f32x4 z[4];
#pragma unroll
    for (int q = 0; q < 4; ++q) z[q] = *(const f32x4*)(Win + (size_t)k * EVEN_IN + 2560 + 4 * q);
#pragma unroll 4
    for (int jj = 0; jj < 32; ++jj) { float acc = 0.f;
#pragma unroll
        for (int r = 0; r < 16; ++r) acc += z[r >> 2][r & 3] * wup[r * 256 + 32 * jb + jj];
        scr[lane * 33 + jj] = acc; }
    LDS_WAIT(); asm volatile("" ::: "memory");
    p0_write_tile(WT, D, 2560 + 32 * jb, 64 * kb, scr, lane);
}
__device__ __forceinline__ void p0a_phase(Frame& F) {
    PHASE_IDS
    if (F.vcu < 192) {
        LAS float* sc = (LAS float*)F.lds; LAS float* red = (LAS float*)(F.lds + 32768);
        for (int i = tid; i < BATCH * D; i += NWAVES * 64) { const float cv = inp(1)[i]; sc[i] = cv / (1.f + expf(-cv)); }
        __syncthreads();
        for (int item = F.vcu; item < 192; item += F.G) {
            const int ls = item / 48, cb = item % 48, col = cb * 64 + lane; const float* w = inp(2) + (size_t)ls * D * 3072 + col;
            float acc[8];
#pragma unroll
            for (int b = 0; b < 8; ++b) acc[b] = 0.f;
#pragma unroll 4
            for (int kk = 0; kk < 128; ++kk) { const int k = wave * 128 + kk; const float wv = w[(size_t)k * 3072];
#pragma unroll
                for (int b = 0; b < 8; ++b) acc[b] += sc[b * D + k] * wv; }
#pragma unroll
            for (int b = 0; b < 8; ++b) red[(wave * 8 + b) * 64 + lane] = acc[b];
            __syncthreads();
            { const int b = tid >> 6, l = tid & 63; float s = inp(3)[ls * 3072 + cb * 64 + l];
#pragma unroll
              for (int w8 = 0; w8 < 8; ++w8) s += red[(w8 * 8 + b) * 64 + l];
              WSP(float, WS_MOD)[(size_t)(ls * 8 + b) * 3072 + cb * 64 + l] = s; }
            __syncthreads();
        }
    }
    __syncthreads();
    LAS float* scr = (LAS float*)(F.lds + 49152 + wave * 8448);
    const int gw = F.vcu * NWAVES + wave, NGW = F.G * NWAVES;
    constexpr int I_IN0 = 16 * 80, I_ZUP = 128, I_OUT = 16 * 32, I_W1 = 16 * 128, I_W2 = 64 * 32, I_IN1 = 16 * 129;
    constexpr int NITEMS = I_IN0 + I_ZUP + 2 * I_OUT + 2 * I_W1 + 2 * I_W2 + I_IN1;
    for (int it = gw; it < NITEMS; it += NGW) {
        int r = it;
        if (r < I_IN0) { p0_transpose_item(inp(6), EVEN_IN, 2560, D, 80, WSP(bf16, WS_WIN0), 0, scr, r, lane); continue; } r -= I_IN0;
        if (r < I_ZUP) { p0_zup_item(inp(6), inp(14), WSP(bf16, WS_WIN0), scr, r, lane); continue; } r -= I_ZUP;
        if (r < I_OUT) { p0_transpose_item(inp(17), D, D, D, 32, WSP(bf16, WS_WOUT0), 0, scr, r, lane); continue; } r -= I_OUT;
        if (r < I_OUT) { p0_transpose_item(inp(22), D, D, D, 32, WSP(bf16, WS_WOUT1), 0, scr, r, lane); continue; } r -= I_OUT;
        if (r < I_W1) { p0_transpose_item(inp(23), FF, FF, D, 128, WSP(bf16, WS_W1_0), 0, scr, r, lane); continue; } r -= I_W1;
        if (r < I_W1) { p0_transpose_item(inp(23) + (size_t)D * FF, FF, FF, D, 128, WSP(bf16, WS_W1_1), 0, scr, r, lane); continue; } r -= I_W1;
        if (r < I_W2) { p0_transpose_item(inp(25), D, D, FF, 32, WSP(bf16, WS_W2_0), 0, scr, r, lane); continue; } r -= I_W2;
        if (r < I_W2) { p0_transpose_item(inp(25) + (size_t)FF * D, D, D, FF, 32, WSP(bf16, WS_W2_1), 0, scr, r, lane); continue; } r -= I_W2;
        p0_transpose_item(inp(18), ODD_IN, ODD_IN, D, 129, WSP(bf16, WS_WIN1), 0, scr, r, lane);
    }
    { const int gt = F.vcu * NWAVES * 64 + tid, NGT = F.G * NWAVES * 64; v4u* z = (v4u*)(WSP(bf16, WS_WIN1) + (size_t)4128 * D);
      for (int i = gt; i < (N1 - 4128) * D * 2 / 16; i += NGT) z[i] = (v4u){0u, 0u, 0u, 0u};
      for (int i = gt; i < N0; i += NGT) WSP(float, WS_BIAS0)[i] = (i < 2560) ? 0.f : inp(15)[i - 2560]; }
}
__device__ __forceinline__ void modulate_phase(Frame& F, const float* x, const float* mod  , bf16* U) {
    PHASE_IDS
    const int gw = F.vcu * NWAVES + wave, NGW = F.G * NWAVES;
    for (int m = gw; m < M; m += NGW) {
        const GAS f32x4* xr = (const GAS f32x4*)(x + (size_t)m * D) + lane; const float* md = mod + (size_t)(m / SEQ) * 3072;
        GAS unsigned long long* o8 = (GAS unsigned long long*)(U + (size_t)m * D) + lane;
#pragma unroll
        for (int j = 0; j < 4; ++j) { const f32x4 v = xr[64 * j]; const f32x4 sh = *(const f32x4*)(md + 4 * lane + 256 * j), scl = *(const f32x4*)(md + D + 4 * lane + 256 * j);
            const f32x4 u = v * (scl + 1.0f) + sh; o8[64 * j] = (unsigned long long)pk2(u.x, u.y) | ((unsigned long long)pk2(u.z, u.w) << 32); }
    }
}
template <bool HAS_NEXT> __device__ __forceinline__ void ln_phase(Frame& F, float* xbuf, const float* g, const float* bb, const float* modn, bf16* U) {
    PHASE_IDS
    const int gw = F.vcu * NWAVES + wave, NGW = F.G * NWAVES;
    for (int m = gw; m < M; m += NGW) {
        GAS f32x4* xr = (GAS f32x4*)(xbuf + (size_t)m * D) + lane;
        f32x4 v[4]; float s = 0.f;
#pragma unroll
        for (int j = 0; j < 4; ++j) { v[j] = xr[64 * j]; s += (v[j].x + v[j].y) + (v[j].z + v[j].w); }
        const float mean = wave_sum(s) * (1.f / D); float s2 = 0.f;
#pragma unroll
        for (int j = 0; j < 4; ++j) { v[j] = v[j] - mean; s2 += (v[j].x * v[j].x + v[j].y * v[j].y) + (v[j].z * v[j].z + v[j].w * v[j].w); }
        const float rstd = 1.f / sqrtf(wave_sum(s2) * (1.f / D) + LN_EPS);
        const float* md = HAS_NEXT ? modn + (size_t)(m / SEQ) * 3072 : nullptr;
        GAS unsigned long long* o8 = (GAS unsigned long long*)(U + (size_t)m * D) + lane;
#pragma unroll
        for (int j = 0; j < 4; ++j) { const int col = 4 * lane + 256 * j; const f32x4 y = v[j] * rstd * *(const f32x4*)(g + col) + *(const f32x4*)(bb + col);
            xr[64 * j] = y;
            if (HAS_NEXT) { const f32x4 u = y * (*(const f32x4*)(md + D + col) + 1.0f) + *(const f32x4*)(md + col); o8[64 * j] = (unsigned long long)pk2(u.x, u.y) | ((unsigned long long)pk2(u.z, u.w) << 32); } }
    }
}
template <bool FINAL> __device__ __forceinline__ void rg_pass(Frame& F) {
    PHASE_IDS
    LAS float* xc = (LAS float*)F.lds;
    const int c = tid, n = wave, j = lane;
    float wa[64], wx[64];
#pragma unroll
    for (int i = 0; i < 64; ++i) { wa[i] = inp(9)[(n * 64 + i) * 64 + j]; wx[i] = inp(11)[(n * 64 + i) * 64 + j]; }
    const float ba = inp(10)[c], bx = inp(12)[c], lsl8 = 8.0f * logsigmoid_f(inp(13)[c]);
    const float cw0 = inp(7)[c], cw1 = inp(7)[512 + c], cw2 = inp(7)[1024 + c], cw3 = inp(7)[1536 + c], cbv = inp(8)[c];
    const bf16* PROJ = WSP(bf16, WS_PROJ);
    for (int unit = F.vcu; unit < BATCH * 128; unit += F.G) {
        const int b = unit >> 7, ci = unit & 127; const size_t row0 = (size_t)b * SEQ + ci * 32;
        const bf16* xr = PROJ + row0 * N0 + c;
        float x0 = 0.f, x1 = 0.f, x2 = 0.f;
        if (ci > 0) { x0 = bf2f(xr[-3 * N0]); x1 = bf2f(xr[-2 * N0]); x2 = bf2f(xr[-1 * N0]); }
#pragma unroll 8
        for (int t = 0; t < 32; ++t) { const float x3 = bf2f(xr[(size_t)t * N0]); xc[t * 512 + c] = cbv + cw0 * x0 + cw1 * x1 + cw2 * x2 + cw3 * x3; x0 = x1; x1 = x2; x2 = x3; }
        __syncthreads();
        float h = FINAL ? WSP(float, WS_RGC)[(size_t)unit * 512 + c] : 0.f, P = 1.f;
#pragma unroll 1
        for (int t = 0; t < 32; ++t) {
            float ra = ba, rx = bx;
#pragma unroll
            for (int i4 = 0; i4 < 16; ++i4) { const f32x4 xv = *(const LAS f32x4*)(xc + t * 512 + n * 64 + 4 * i4);
#pragma unroll
                for (int e = 0; e < 4; ++e) { ra += xv[e] * wa[4 * i4 + e]; rx += xv[e] * wx[4 * i4 + e]; } }
            const float r = 1.f / (1.f + expf(-ra)), ig = 1.f / (1.f + expf(-rx));
            const float log_a = lsl8 * r, a = expf(log_a), mult = sqrtf(-expm1f(2.f * log_a));
            h = a * h + mult * (ig * xc[t * 512 + c]);
            if (FINAL) { const float yr = bf2f(PROJ[(row0 + t) * N0 + 512 + c]); WSP(bf16, WS_MIX)[(row0 + t) * D + c] = (bf16)f2bf(h * gelu_tanh_f(yr)); }
            else P *= a;
        }
        if (!FINAL) { WSP(float, WS_RGP)[(size_t)unit * 512 + c] = P; WSP(float, WS_RGH)[(size_t)unit * 512 + c] = h; }
        __syncthreads();
    }
}
template <bool FINAL> __device__ __forceinline__ void gla_pass(Frame& F) {
    PHASE_IDS
    const int us = wave >> 1, dvh = wave & 1;
    LAS float* ql = (LAS float*)(F.lds + us * 28672); LAS float* kl = ql + 1024; LAS float* al = ql + 2048;
    LAS float* vl = ql + 3072; LAS float* gl = ql + 5120;
    LAS float* part = (LAS float*)(F.lds + 114688) + us * 32;
    const bf16* PROJ = WSP(bf16, WS_PROJ); float* KV = WSP(float, WS_GKV);
    for (int ub = F.vcu * 4; ub < BATCH * 4 * 64; ub += F.G * 4) {
        const int unit = ub + us; const bool act = unit < BATCH * 4 * 64;
        const int bh = unit >> 6, nch = unit & 63, b = bh >> 2, h = bh & 3; const size_t row0 = (size_t)b * SEQ + nch * 64; const int vcol = h * 128 + dvh * 64 + lane, lcol = dvh * 64 + lane;
        float S[64];
#pragma unroll
        for (int dk = 0; dk < 64; ++dk) S[dk] = (FINAL && act) ? KV[((size_t)unit * 64 + dk) * 128 + lcol] : 0.f;
        float sum_la = 0.f;
        const float gn = (FINAL && act) ? inp(16)[vcol] : 0.f;
#pragma unroll 1
        for (int sb = 0; sb < 4; ++sb) {
            if (act) { const bf16* p0 = PROJ + (row0 + sb * 16) * N0;
#pragma unroll 4
                for (int tt = 0; tt < 16; ++tt) { const bf16* p = p0 + (size_t)tt * N0;
                    if (dvh == 0) { ql[tt * 64 + lane] = bf2f(p[1024 + h * 64 + lane]) * 0.125f; kl[tt * 64 + lane] = bf2f(p[1280 + h * 64 + lane]); }
                    else { const float la = logsigmoid_f(bf2f(p[2560 + h * 64 + lane])) * (1.f / 16.f); sum_la += la; al[tt * 64 + lane] = expf(la); }
                    vl[tt * 128 + lcol] = bf2f(p[1536 + vcol]); if (FINAL) gl[tt * 128 + lcol] = bf2f(p[2048 + vcol]); } }
            __syncthreads();
            if (act) {
#pragma unroll 1
                for (int tt = 0; tt < 16; ++tt) { const float v0 = vl[tt * 128 + lcol]; float o0 = 0.f;
#pragma unroll
                    for (int d4 = 0; d4 < 16; ++d4) { const f32x4 a4 = *(const LAS f32x4*)(al + tt * 64 + 4 * d4), k4 = *(const LAS f32x4*)(kl + tt * 64 + 4 * d4), q4 = *(const LAS f32x4*)(ql + tt * 64 + 4 * d4);
#pragma unroll
                        for (int e = 0; e < 4; ++e) { const int dk = 4 * d4 + e; S[dk] = a4[e] * S[dk] + k4[e] * v0; o0 += q4[e] * S[dk]; } }
                    if (FINAL) { vl[tt * 128 + lcol] = o0; const float ssq = wave_sum(o0 * o0); if (lane == 0) part[dvh * 16 + tt] = ssq; } }
            }
            __syncthreads();
            if (FINAL && act) {
#pragma unroll 4
                for (int tt = 0; tt < 16; ++tt) { const float ss = part[tt] + part[16 + tt], ri = 1.f / sqrtf(ss * (1.f / 128.f) + 1e-6f), g0 = gl[tt * 128 + lcol];
                    WSP(bf16, WS_MIX)[(row0 + sb * 16 + tt) * D + 512 + vcol] = (bf16)f2bf(vl[tt * 128 + lcol] * ri * gn * (g0 / (1.f + expf(-g0)))); }
            }
            __syncthreads();
        }
        if (!FINAL && act) {
#pragma unroll
            for (int dk = 0; dk < 64; ++dk) KV[((size_t)unit * 64 + dk) * 128 + lcol] = S[dk];
            if (dvh == 1) WSP(float, WS_GDEC)[(size_t)unit * 64 + lane] = expf(sum_la);
        }
    }
}
__device__ __forceinline__ void chunk_scan_phase(Frame& F) {
    PHASE_IDS
    const int gt = F.vcu * NWAVES * 64 + tid, NGT = F.G * NWAVES * 64;
    float* KV = WSP(float, WS_GKV); const float* DEC = WSP(float, WS_GDEC);
    for (int idx = gt; idx < 32 * 8192; idx += NGT) {
        const int bh = idx >> 13, r = idx & 8191, dk = r >> 7; float S = 0.f;
#pragma unroll 1
        for (int n0 = 0; n0 < 64; n0 += 8) { float kv[8], dc[8];
#pragma unroll
            for (int q = 0; q < 8; ++q) { kv[q] = KV[((size_t)(bh * 64 + n0 + q)) * 8192 + r]; dc[q] = DEC[(bh * 64 + n0 + q) * 64 + dk]; }
#pragma unroll
            for (int q = 0; q < 8; ++q) { KV[((size_t)(bh * 64 + n0 + q)) * 8192 + r] = S; S = dc[q] * S + kv[q]; } }
    }
    const float* P = WSP(float, WS_RGP); const float* H = WSP(float, WS_RGH); float* C = WSP(float, WS_RGC);
    for (int idx = gt; idx < BATCH * 512; idx += NGT) {
        const int b = idx >> 9, c = idx & 511; float h = 0.f;
#pragma unroll 1
        for (int n0 = 0; n0 < 128; n0 += 8) { float pv[8], hv[8];
#pragma unroll
            for (int q = 0; q < 8; ++q) { pv[q] = P[(size_t)(b * 128 + n0 + q) * 512 + c]; hv[q] = H[(size_t)(b * 128 + n0 + q) * 512 + c]; }
#pragma unroll
            for (int q = 0; q < 8; ++q) { C[(size_t)(b * 128 + n0 + q) * 512 + c] = h; h = pv[q] * h + hv[q]; } }
    }
}
__device__ __forceinline__ void fcum_phase(Frame& F) {
    PHASE_IDS
    const int gw = F.vcu * NWAVES + wave, NGW = F.G * NWAVES;
    for (int u = gw; u < BATCH * 16; u += NGW) {
        const int b = u >> 4, h = u & 15; const float bf = inp(19)[h]; const float* fl = WSP(float, WS_FL) + ((size_t)b * SEQ + lane * 64) * 16 + h;
        float v[64]; float s = 0.f;
#pragma unroll
        for (int i = 0; i < 64; ++i) { v[i] = logsigmoid_f(fl[i * 16] + bf); s += v[i]; }
        float incl = s;
#pragma unroll
        for (int o = 1; o < 64; o <<= 1) { const float t = __shfl_up(incl, o); if (lane >= o) incl += t; }
        float run = incl - s; float* kb = WSP(float, WS_KB) + (size_t)u * SEQ + lane * 64;
#pragma unroll
        for (int i4 = 0; i4 < 16; ++i4) { f32x4 o;
#pragma unroll
            for (int e = 0; e < 4; ++e) { run += v[4 * i4 + e]; o[e] = -1.4426950408889634f * run; }
            *(f32x4*)(kb + 4 * i4) = o; }
    }
}
struct Args { const float* in[27]; float* out; unsigned char* ws; };
__global__ void __launch_bounds__(NWAVES * 64, 2) mega_fwd(Args args) {
    extern __shared__ __attribute__((aligned(16))) unsigned char lds[];
    Frame F;
    F.lds = (LAS unsigned char*)lds; F.MISC = (volatile LAS unsigned*)(F.lds + MISC_OFF);
    F.G = gridDim.x; { const int bx = blockIdx.x; F.vcu = (F.G % 8 == 0) ? (bx % 8) * (F.G / 8) + bx / 8 : bx; }
    F.ws = args.ws; F.ctl = (gu32*)(args.ws + WS_CTL);
    for (int u = threadIdx.x; u < (LDS_BYTES - LDSCTL_OFF) / 4; u += NWAVES * 64) ((LAS unsigned*)(F.lds + LDSCTL_OFF))[u] = 0u;
    __syncthreads();
    XcdBarrier bar = xcd_barrier_post((unsigned*)(F.ctl + CW_BAR), F.MISC + 8);
#define GRID_BAR() xcd_barrier(bar)
#define MODP(l, s) (WSP(float, WS_MOD) + (size_t)((l) * 2 + (s)) * BATCH * 3072)
#define GEMM_MULTI(EpiT, E, Aop, Bop, Nn, Kk) do { pg8::Gemm g_{(const pg8::bf16_t*)(Aop), (const pg8::bf16_t*)(Bop), M, (Nn), (Kk)}; pg8::StaticOrder S_; S_.init(M, (Nn), F.G, (int)blockIdx.x); \
        pg8::gemm_phase<EpiT, pg8::StaticOrder, PG8_ALIGN, PG8_SP2>(F.lds, g_, S_, (E)); } while (0)

    p0a_phase(F);
    cg::this_grid().sync();
    modulate_phase(F, inp(0), MODP(0, 0), WSP(bf16, WS_U));
    GRID_BAR();
    { pg8::EpiBf16<0> E{(pg8::bf16_t*)WSP(bf16, WS_PROJ), N0, WSP(float, WS_BIAS0), 0, 0, 1.f}; GEMM_MULTI(pg8::EpiBf16<0>, E, WSP(bf16, WS_U), WSP(bf16, WS_WIN0), N0, D); }
    GRID_BAR();
    rg_pass<false>(F); __syncthreads(); gla_pass<false>(F);
    GRID_BAR();
    chunk_scan_phase(F);
    GRID_BAR();
    rg_pass<true>(F); __syncthreads(); gla_pass<true>(F);
    GRID_BAR();
    { pg8::EpiResid E{inp(0), ((float*)inp(27)), nullptr, MODP(0, 0)}; GEMM_MULTI(pg8::EpiResid, E, WSP(bf16, WS_MIX), WSP(bf16, WS_WOUT0), D, D); }
    GRID_BAR();
    ln_phase<true>(F, ((float*)inp(27)), inp(4), inp(5), MODP(0, 1), WSP(bf16, WS_U));
    GRID_BAR();
    { pg8::EpiBf16<2> E{(pg8::bf16_t*)WSP(bf16, WS_PROJ), FF, inp(24), 0, 0, 1.f}; GEMM_MULTI(pg8::EpiBf16<2>, E, WSP(bf16, WS_U), WSP(bf16, WS_W1_0), FF, D); }
    GRID_BAR();
    { pg8::EpiResid E{((float*)inp(27)), ((float*)inp(27)), inp(26), MODP(0, 1)}; GEMM_MULTI(pg8::EpiResid, E, WSP(bf16, WS_PROJ), WSP(bf16, WS_W2_0), D, FF); }
    GRID_BAR();
    ln_phase<true>(F, ((float*)inp(27)), inp(4) + D, inp(5) + D, MODP(1, 0), WSP(bf16, WS_U));
    GRID_BAR();
    { pg8::EpiQKVG E{(pg8::bf16_t*)WSP(bf16, WS_PROJ), QKVG_STRIDE, WSP(float, WS_FL), inp(20), inp(21), attn_body::C2}; GEMM_MULTI(pg8::EpiQKVG, E, WSP(bf16, WS_U), WSP(bf16, WS_WIN1), N1, D); }
    GRID_BAR();
    fcum_phase(F);
    GRID_BAR();
    { const attn_body::AttnTensors AT{(const attn_body::bf16*)WSP(bf16, WS_PROJ), (const attn_body::bf16*)(WSP(bf16, WS_PROJ) + QKVG_STRIDE), (const attn_body::bf16*)(WSP(bf16, WS_PROJ) + 2 * QKVG_STRIDE),
                                      (attn_body::bf16*)WSP(bf16, WS_PROJ), (const attn_body::bf16*)(WSP(bf16, WS_PROJ) + 3 * QKVG_STRIDE), WSP(float, WS_KB)};
      const attn_body::StaticOrder S((int)F.G, (int)blockIdx.x);
      attn_body::attn_phase<attn_body::StaticOrder>((char*)lds, AT, S); }
    GRID_BAR();
    { pg8::EpiResid E{((float*)inp(27)), ((float*)inp(27)), nullptr, MODP(1, 0)}; GEMM_MULTI(pg8::EpiResid, E, WSP(bf16, WS_PROJ), WSP(bf16, WS_WOUT1), D, D); }
    GRID_BAR();
    ln_phase<true>(F, ((float*)inp(27)), inp(4) + 2 * D, inp(5) + 2 * D, MODP(1, 1), WSP(bf16, WS_U));
    GRID_BAR();
    { pg8::EpiBf16<2> E{(pg8::bf16_t*)WSP(bf16, WS_PROJ), FF, inp(24) + FF, 0, 0, 1.f}; GEMM_MULTI(pg8::EpiBf16<2>, E, WSP(bf16, WS_U), WSP(bf16, WS_W1_1), FF, D); }
    GRID_BAR();
    { pg8::EpiResid E{((float*)inp(27)), ((float*)inp(27)), inp(26) + D, MODP(1, 1)}; GEMM_MULTI(pg8::EpiResid, E, WSP(bf16, WS_PROJ), WSP(bf16, WS_W2_1), D, FF); }
    GRID_BAR();
    ln_phase<false>(F, ((float*)inp(27)), inp(4) + 3 * D, inp(5) + 3 * D, nullptr, WSP(bf16, WS_U));
}

extern "C" void kernel_launch(void* const* d_in, const int* in_sizes, int n_in, void* d_out, int out_size, void* d_ws, size_t ws_size, hipStream_t stream) {
    static int grid = 0;
    if (grid == 0) {
        if (n_in != 27 || in_sizes[0] != M * D || out_size != M * D || ws_size < WS_END) { fprintf(stderr, "kernel_launch: unexpected shapes (n_in %d, in0 %d, out %d, ws %zu); nothing launched\n", n_in, n_in > 0 ? in_sizes[0] : -1, out_size, ws_size); grid = -1; return; }
        int dev = 0, cus = 0, per_cu = 0;
        if (hipGetDevice(&dev) != hipSuccess || hipDeviceGetAttribute(&cus, hipDeviceAttributeMultiprocessorCount, dev) != hipSuccess) { grid = -1; return; }
        if (hipFuncSetAttribute((const void*)mega_fwd, hipFuncAttributeMaxDynamicSharedMemorySize, LDS_BYTES) != hipSuccess) { fprintf(stderr, "kernel_launch: hipFuncSetAttribute failed\n"); grid = -1; return; }
        if (hipOccupancyMaxActiveBlocksPerMultiprocessor(&per_cu, (const void*)mega_fwd, NWAVES * 64, LDS_BYTES) != hipSuccess || per_cu < 1) { fprintf(stderr, "kernel_launch: occupancy query says %d blocks per CU; nothing launched\n", per_cu); (void)hipGetLastError(); grid = -1; return; }
        grid = cus * per_cu;
    }
    if (grid < 0) return;
    if (hipMemsetAsync((char*)d_ws + WS_CTL, 0, CTL_ZERO_BYTES, stream) != hipSuccess) { fprintf(stderr, "kernel_launch: memset failed\n"); return; }
    Args a{};
    for (int i = 0; i < 27; ++i) a.in[i] = (const float*)d_in[i];
    a.out = (float*)d_out; a.ws = (unsigned char*)d_ws;
    void* kargs[] = {&a};
    const hipError_t e = hipLaunchCooperativeKernel((const void*)mega_fwd, dim3(grid), dim3(NWAVES * 64), kargs, LDS_BYTES, stream);
    if (e != hipSuccess) fprintf(stderr, "kernel_launch: cooperative launch failed: %s (grid %d)\n", hipGetErrorString(e), grid);
}
```

```cpp
#include <hip/hip_runtime.h>
#include <hip/hip_cooperative_groups.h>
#include <cstdio>
#include <cstdint>

namespace pg8 {
#define PG8_LAS __attribute__((address_space(3)))
typedef unsigned short bf16_t;
typedef short bf16x8 __attribute__((ext_vector_type(8)));
typedef float f32x4 __attribute__((ext_vector_type(4)));
typedef unsigned u32x4 __attribute__((ext_vector_type(4)));
constexpr int BM = 256, BK = 64, HALF = 128, HTB = HALF * BK * 2  , STAGE_BYTES = 8 * HTB, NXCD = 8, WGM = 8;

__host__ __device__ __forceinline__ int lds_byte(int r, int c) { const int st = (r >> 4) * 2 + (c >> 5), rr = r & 15, cc = c & 31, ob = rr * 64 + cc * 2; return st * 1024 + (ob ^ (((ob >> 9) & 1) << 5)); }
__host__ __device__ __forceinline__ void stage_rc(int b, int& R, int& C) { const int st = b / 1024, sb = b % 1024, swz = sb ^ (((sb >> 9) & 1) << 5); R = (st >> 1) * 16 + swz / 64; C = (st & 1) * 32 + (swz % 64) / 2; }
__host__ __device__ __forceinline__ int perm32(int rho) { const int n = rho >> 4, i = rho & 15; return 8 * (i >> 2) + 4 * n + (i & 3); }

struct Unit { int pm, pn; };
struct Gemm { const bf16_t* A; const bf16_t* Bt; int M, N, K; };

struct StaticOrder {
    int nM, nN, nwg, G, c;
    __host__ __device__ void init(int M, int N, int G_, int c_) { nM = M / BM; nN = N / BM; nwg = nM * nN; G = G_; c = c_; }
    __host__ __device__ bool next(int i, Unit& u) const {
        const long L = (long)i * G + c; if (L >= nwg) return false;
        int wgid = (int)L; { const int q = nwg / NXCD, r = nwg % NXCD, xcd = wgid % NXCD, off = wgid / NXCD; wgid = (xcd < r ? xcd * (q + 1) : r * (q + 1) + (xcd - r) * q) + off; }
        const int nig = WGM * nN, gid = wgid / nig, fm = gid * WGM, gsz = (nM - fm) < WGM ? (nM - fm) : WGM;
        u.pm = fm + ((wgid % nig) % gsz); u.pn = (wgid % nig) / gsz; return true;
    }
    __device__ __forceinline__ void a_ready(const Unit&) const {}
    __device__ __forceinline__ void done(const Unit&) const {}
};

__device__ __forceinline__ unsigned cvt_pk_bf16(float lo, float hi) { unsigned r; asm volatile("v_cvt_pk_bf16_f32 %0, %1, %2" : "=v"(r) : "v"(lo), "v"(hi)); return r; }
typedef float f32x2 __attribute__((ext_vector_type(2)));
__device__ __forceinline__ f32x2 gelu_pk(f32x2 v) {
    const f32x2 av = __builtin_elementwise_abs(v), d = av * 0.2316418882f + 1.0f;
    f32x2 t; t.x = __builtin_amdgcn_rcpf(d.x); t.y = __builtin_amdgcn_rcpf(d.y);
    f32x2 q = t * 0.5307027145f + (-0.7265760135f); q = q * t + 0.7107068705f; q = q * t + (-0.142248368f); q = q * t + 0.127414796f; q = q * t;
    const f32x2 s = (v * v) * (-0.72134752044f);
    f32x2 e; e.x = __builtin_amdgcn_exp2f(s.x); e.y = __builtin_amdgcn_exp2f(s.y);
    const f32x2 m = v * (q * e), r = v - m;
    f32x2 o; o.x = v.x < 0.f ? m.x : r.x; o.y = v.y < 0.f ? m.y : r.y; return o;
}

template <int ACT  > struct EpiBf16 {
    static constexpr bool PERM = true, AFTER_DRAIN = false, HEADPERM = false; static_assert(ACT == 0 || ACT == 1 || ACT == 2, "EpiBf16: ACT is 0 (none), 1 (gelu_pk) or 2 (relu^2)");
    bf16_t* O; int ldc; const float* bias; int split_cols; size_t split_stride; float scale0;
    __device__ __forceinline__ void operator()(const f32x4 (&acc)[2][2][4][2], const Unit& u, int wr, int wc, int fr, int fq) const {
        const int row0 = u.pm * BM + wr * 64 + fr; int colt = u.pn * BM; bf16_t* base = O;
        float sc = 1.f; if (split_cols) { const int t = colt / split_cols; base += (size_t)t * split_stride; colt -= t * split_cols; if (t == 0) sc = scale0; }
        const int col0 = colt + wc * 32 + 8 * fq, bcol0 = u.pn * BM + wc * 32 + 8 * fq;
        f32x4 bv[2][2];
#pragma unroll
        for (int bj = 0; bj < 2; ++bj)
#pragma unroll
            for (int n = 0; n < 2; ++n) bv[bj][n] = bias ? *(const f32x4*)(bias + bcol0 + bj * HALF + 4 * n) : (f32x4){0.f, 0.f, 0.f, 0.f};
#pragma unroll
        for (int ai = 0; ai < 2; ++ai)
#pragma unroll
            for (int m = 0; m < 4; ++m) { bf16_t* rowp = base + (size_t)(row0 + ai * HALF + m * 16) * ldc + col0;
#pragma unroll
                for (int bj = 0; bj < 2; ++bj) { f32x4 v0 = acc[ai][bj][m][0] + bv[bj][0], v1 = acc[ai][bj][m][1] + bv[bj][1];
                    if (ACT == 1) { f32x2 a = gelu_pk((f32x2){v0[0], v0[1]}), b = gelu_pk((f32x2){v0[2], v0[3]}), c = gelu_pk((f32x2){v1[0], v1[1]}), d = gelu_pk((f32x2){v1[2], v1[3]});
                        v0 = (f32x4){a.x, a.y, b.x, b.y}; v1 = (f32x4){c.x, c.y, d.x, d.y}; }
                    if (ACT == 2) { _Pragma("unroll") for (int e_ = 0; e_ < 4; ++e_) { const float a_ = fmaxf(v0[e_], 0.f), b_ = fmaxf(v1[e_], 0.f); v0[e_] = a_ * a_; v1[e_] = b_ * b_; } }
                    v0 = v0 * sc; v1 = v1 * sc; u32x4 w; w.x = cvt_pk_bf16(v0[0], v0[1]); w.y = cvt_pk_bf16(v0[2], v0[3]); w.z = cvt_pk_bf16(v1[0], v1[1]); w.w = cvt_pk_bf16(v1[2], v1[3]);
                    *(u32x4*)(rowp + bj * HALF) = w; } }
    }
};
typedef unsigned u32x2 __attribute__((ext_vector_type(2)));
struct EpiResid {
    static constexpr bool PERM = false, AFTER_DRAIN = false, HEADPERM = false;
    const float* base; float* out; const float* bias; const float* mod;
    __device__ __forceinline__ void operator()(const f32x4 (&acc)[2][2][4][2], const Unit& u, int wr, int wc, int fr, int fq) const {
        const int col0 = u.pn * BM + wc * 32 + 4 * fq; const float* mg = mod + (size_t)(u.pm >> 4) * 3072 + 2048;
        f32x4 gv[2][2], bv[2][2];
#pragma unroll
        for (int bj = 0; bj < 2; ++bj)
#pragma unroll
            for (int n = 0; n < 2; ++n) { gv[bj][n] = *(const f32x4*)(mg + col0 + bj * HALF + n * 16) + 1.0f; bv[bj][n] = bias ? *(const f32x4*)(bias + col0 + bj * HALF + n * 16) : (f32x4){0.f, 0.f, 0.f, 0.f}; }
#pragma unroll
        for (int ai = 0; ai < 2; ++ai)
#pragma unroll
            for (int m = 0; m < 4; ++m) { const size_t off = (size_t)(u.pm * BM + ai * HALF + wr * 64 + m * 16 + fr) * 1024 + col0;
#pragma unroll
                for (int bj = 0; bj < 2; ++bj)
#pragma unroll
                    for (int n = 0; n < 2; ++n) { const f32x4 bs = *(const f32x4*)(base + off + bj * HALF + n * 16);
                        *(f32x4*)(out + off + bj * HALF + n * 16) = bs * 1.41421356237309515f + gv[bj][n] * (acc[ai][bj][m][n] + bv[bj][n]); }
                if (m & 1) asm volatile("" ::: "memory"); }
    }
};
struct EpiQKVG {
    static constexpr bool PERM = true, AFTER_DRAIN = false, HEADPERM = true;
    bf16_t* qkvg; size_t stride; float* fl; const float* qg; const float* kg; float scale0;
    __device__ __forceinline__ void operator()(const f32x4 (&acc)[2][2][4][2], const Unit& u, int wr, int wc, int fr, int fq) const {
        const int row0 = u.pm * BM + wr * 64 + fr;
        if (u.pn == 16) {
            if (wc == 0 && fq < 2) {
#pragma unroll
                for (int ai = 0; ai < 2; ++ai)
#pragma unroll
                    for (int m = 0; m < 4; ++m) { float* p = fl + (size_t)(row0 + ai * HALF + m * 16) * 16 + 8 * fq; *(f32x4*)p = acc[ai][0][m][0]; *(f32x4*)(p + 4) = acc[ai][0][m][1]; }
            }
            return;
        }
        const int t = u.pn >> 2; bf16_t* dst = qkvg + (size_t)t * stride + (u.pn & 3) * 256 + wc * 64 + 8 * fq;
        f32x4 gv[2][2]; const float* gsrc = (t == 0) ? qg : kg; const float sc = (t == 0) ? scale0 : 1.0f;
        if (t < 2) {
#pragma unroll
            for (int bj = 0; bj < 2; ++bj)
#pragma unroll
                for (int n = 0; n < 2; ++n) gv[bj][n] = *(const f32x4*)(gsrc + 32 * bj + 8 * fq + 4 * n) * sc;
        }
#pragma unroll
        for (int ai = 0; ai < 2; ++ai)
#pragma unroll
            for (int m = 0; m < 4; ++m) { bf16_t* rowp = dst + (size_t)(row0 + ai * HALF + m * 16) * 1024;
                f32x4 v[2][2];
#pragma unroll
                for (int bj = 0; bj < 2; ++bj)
#pragma unroll
                    for (int n = 0; n < 2; ++n) v[bj][n] = acc[ai][bj][m][n];
                if (t < 2) { float ss = 0.f;
#pragma unroll
                    for (int bj = 0; bj < 2; ++bj)
#pragma unroll
                        for (int n = 0; n < 2; ++n) { const f32x4 x = v[bj][n]; ss += (x[0] * x[0] + x[1] * x[1]) + (x[2] * x[2] + x[3] * x[3]); }
                    ss += __shfl_xor(ss, 16); ss += __shfl_xor(ss, 32);
                    const float ri = 1.0f / sqrtf(ss * (1.0f / 64.0f) + 1e-6f);
#pragma unroll
                    for (int bj = 0; bj < 2; ++bj)
#pragma unroll
                        for (int n = 0; n < 2; ++n) v[bj][n] = v[bj][n] * ri * gv[bj][n]; }
#pragma unroll
                for (int bj = 0; bj < 2; ++bj) { u32x4 w; w.x = cvt_pk_bf16(v[bj][0][0], v[bj][0][1]); w.y = cvt_pk_bf16(v[bj][0][2], v[bj][0][3]); w.z = cvt_pk_bf16(v[bj][1][0], v[bj][1][1]); w.w = cvt_pk_bf16(v[bj][1][2], v[bj][1][3]);
                    *(u32x4*)(rowp + 32 * bj) = w; } }
    }
};

template <class Epi, class Sched, bool ALIGN_EPI = false, bool SP2 = false>
__device__ __forceinline__ void gemm_phase(PG8_LAS unsigned char* lds, const Gemm g, const Sched& S, const Epi& E) {
    int tid_g_ = threadIdx.x; asm volatile("" : "+v"(tid_g_)); const int tid = tid_g_, wid = __builtin_amdgcn_readfirstlane(tid >> 6), lane = tid & 63, wr = wid >> 2, wc = wid & 3, fr = lane & 15, fq = lane >> 4;
    const int K = g.K, nt = K / BK;
    unsigned voffA[2], voffB[2];
#pragma unroll
    for (int i = 0; i < 2; ++i) { int R, C; stage_rc(tid * 16 + i * 8192, R, C); const int Rb = Epi::HEADPERM ? (64 * (R >> 5) + perm32(R & 31)) : (Epi::PERM ? ((R & ~31) + perm32(R & 31)) : R);
        voffA[i] = (unsigned)(R * K + C) * 2u; voffB[i] = (unsigned)(Rb * K + C) * 2u; }
    const size_t kstep = (size_t)(BK * 2);
    const size_t hstep = (size_t)HALF * K * 2;
    const size_t tstep = 2 * hstep; const size_t hstepB = Epi::HEADPERM ? (size_t)32 * K * 2 : hstep;
    const unsigned ldsw = (unsigned)wid * 1024u;
    const int aoff = lds_byte(wr * 64 + fr, fq * 8), boff = lds_byte(wc * 32 + fr, fq * 8);
#define PG8_SA(b, h) (((b) * 2 + (h)) * HTB)
#define PG8_SB(b, h) ((4 + (b) * 2 + (h)) * HTB)
#define PG8_STAGE(bufoff, gbase, voff) do { _Pragma("unroll") for (int _i = 0; _i < 2; ++_i) \
        __builtin_amdgcn_global_load_lds((const unsigned*)((const char*)(gbase) + (voff)[_i]), (PG8_LAS unsigned*)(lds + (bufoff) + ldsw + _i * 8192), 16, 0, 0); } while (0)
#define PG8_LDA(dst, b, h) do { _Pragma("unroll") for (int m = 0; m < 4; ++m) _Pragma("unroll") for (int k = 0; k < 2; ++k) dst[m][k] = *(const PG8_LAS bf16x8*)(lds + PG8_SA(b, h) + aoff + m * 2048 + k * 1024); } while (0)
#define PG8_LDB(dst, b, h) do { _Pragma("unroll") for (int n = 0; n < 2; ++n) _Pragma("unroll") for (int k = 0; k < 2; ++k) dst[n][k] = *(const PG8_LAS bf16x8*)(lds + PG8_SB(b, h) + boff + n * 2048 + k * 1024); } while (0)
#define PG8_MMA(ai, bj, At, Bt) do { __builtin_amdgcn_s_setprio(1); _Pragma("unroll") for (int m = 0; m < 4; ++m) _Pragma("unroll") for (int n = 0; n < 2; ++n) _Pragma("unroll") for (int k = 0; k < 2; ++k) \
        acc[ai][bj][m][n] = __builtin_amdgcn_mfma_f32_16x16x32_bf16(Bt[n][k], At[m][k], acc[ai][bj][m][n], 0, 0, 0); __builtin_amdgcn_s_setprio(0); } while (0)
#define PG8_WAIT_V(n) asm volatile("s_waitcnt vmcnt(" #n ")" ::: "memory")
#define PG8_WAIT_L(n) asm volatile("s_waitcnt lgkmcnt(" #n ")" ::: "memory")
#define PG8_BAR __builtin_amdgcn_s_barrier()
#define PG8_SCHED __builtin_amdgcn_sched_barrier(0)
    Unit cur, nxt; int ui = 0;
    if (!S.next(0, cur)) return;
    f32x4 acc[2][2][4][2];
#pragma unroll
    for (int a = 0; a < 2; ++a)
#pragma unroll
        for (int b = 0; b < 2; ++b)
#pragma unroll
            for (int m = 0; m < 4; ++m)
#pragma unroll
                for (int n = 0; n < 2; ++n) acc[a][b][m][n] = (f32x4){0.f, 0.f, 0.f, 0.f};
    bf16x8 At[4][2], B0[2][2], B1[2][2];
    const char* cA = (const char*)g.A + (size_t)cur.pm * tstep; const char* cB = (const char*)g.Bt + (size_t)cur.pn * tstep;
    S.a_ready(cur);
    if constexpr (SP2) {
        PG8_STAGE(PG8_SB(0, 0), cB, voffB); PG8_STAGE(PG8_SB(0, 1), cB + hstepB, voffB); PG8_STAGE(PG8_SA(0, 0), cA, voffA); PG8_STAGE(PG8_SA(0, 1), cA + hstep, voffA);
        if (wr == 1) PG8_BAR;
        PG8_WAIT_V(2); PG8_BAR;
        PG8_STAGE(PG8_SB(1, 0), cB + kstep, voffB); PG8_STAGE(PG8_SA(1, 0), cA + kstep, voffA); PG8_STAGE(PG8_SB(1, 1), cB + hstepB + kstep, voffB);
        PG8_WAIT_V(6); PG8_BAR;
    } else {
        PG8_STAGE(PG8_SB(0, 0), cB, voffB); PG8_STAGE(PG8_SA(0, 0), cA, voffA); PG8_STAGE(PG8_SB(0, 1), cB + hstepB, voffB); PG8_STAGE(PG8_SA(0, 1), cA + hstep, voffA);
        if (wr == 1) PG8_BAR;
        PG8_WAIT_V(4); PG8_BAR;
        PG8_STAGE(PG8_SB(1, 0), cB + kstep, voffB); PG8_STAGE(PG8_SA(1, 0), cA + kstep, voffA); PG8_STAGE(PG8_SB(1, 1), cB + hstepB + kstep, voffB);
        PG8_WAIT_V(6); PG8_BAR;
    }
    for (;;) {
        const bool has_next = S.next(ui + 1, nxt);
        const char* nA = has_next ? (const char*)g.A + (size_t)nxt.pm * tstep : cA; const char* nB = has_next ? (const char*)g.Bt + (size_t)nxt.pn * tstep : cB;
        for (int t = 0; t < nt; t += 2) {
            const bool last = (t == nt - 2);
            const char* a1 = cA + (size_t)(t + 1) * kstep;
            const char* a2 = last ? nA : cA + (size_t)(t + 2) * kstep; const char* b2 = last ? nB : cB + (size_t)(t + 2) * kstep;
            const char* a3 = a2 + kstep; const char* b3 = b2 + kstep;
            if (last && has_next) S.a_ready(nxt);
            if constexpr (SP2) {
            PG8_LDB(B0, 0, 0); PG8_LDB(B1, 0, 1); PG8_SCHED; PG8_LDA(At, 0, 0); PG8_STAGE(PG8_SA(1, 1), a1 + hstep, voffA);
            PG8_WAIT_V(8); PG8_WAIT_L(0); PG8_BAR; PG8_MMA(0, 0, At, B0); PG8_MMA(0, 1, At, B1); PG8_BAR; PG8_SCHED;
            PG8_LDA(At, 0, 1); PG8_STAGE(PG8_SB(0, 0), b2, voffB); PG8_STAGE(PG8_SB(0, 1), b2 + hstepB, voffB); PG8_STAGE(PG8_SA(0, 0), a2, voffA);
            PG8_WAIT_V(8); PG8_WAIT_L(0); PG8_BAR; PG8_MMA(1, 0, At, B0); PG8_MMA(1, 1, At, B1); PG8_BAR; PG8_SCHED;
            PG8_LDB(B0, 1, 0); PG8_LDB(B1, 1, 1); PG8_SCHED; PG8_LDA(At, 1, 0); PG8_STAGE(PG8_SA(0, 1), a2 + hstep, voffA);
            PG8_WAIT_V(8); PG8_WAIT_L(0); PG8_BAR; PG8_MMA(0, 0, At, B0); PG8_MMA(0, 1, At, B1); PG8_BAR; PG8_SCHED;
            PG8_LDA(At, 1, 1); PG8_STAGE(PG8_SB(1, 0), b3, voffB); PG8_STAGE(PG8_SB(1, 1), b3 + hstepB, voffB); PG8_STAGE(PG8_SA(1, 0), a3, voffA);
            PG8_WAIT_V(8); PG8_WAIT_L(0); PG8_BAR; PG8_MMA(1, 0, At, B0); PG8_MMA(1, 1, At, B1); PG8_BAR; PG8_SCHED;
            } else {
            PG8_LDB(B0, 0, 0); PG8_SCHED; PG8_LDA(At, 0, 0); PG8_STAGE(PG8_SA(1, 1), a1 + hstep, voffA);
            PG8_WAIT_L(8); PG8_BAR; PG8_WAIT_L(0); PG8_MMA(0, 0, At, B0); PG8_BAR; PG8_SCHED;
            PG8_LDB(B1, 0, 1); PG8_STAGE(PG8_SB(0, 0), b2, voffB);
            PG8_BAR; PG8_WAIT_L(0); PG8_MMA(0, 1, At, B1); PG8_BAR;
            PG8_LDA(At, 0, 1); PG8_STAGE(PG8_SA(0, 0), a2, voffA);
            PG8_BAR; PG8_WAIT_L(0); PG8_MMA(1, 0, At, B0); PG8_BAR; PG8_SCHED;
            PG8_STAGE(PG8_SB(0, 1), b2 + hstepB, voffB);
            PG8_WAIT_V(6); PG8_BAR; PG8_MMA(1, 1, At, B1); PG8_BAR;
            PG8_LDB(B0, 1, 0); PG8_SCHED; PG8_LDA(At, 1, 0); PG8_STAGE(PG8_SA(0, 1), a2 + hstep, voffA);
            PG8_WAIT_L(8); PG8_BAR; PG8_WAIT_L(0); PG8_MMA(0, 0, At, B0); PG8_BAR; PG8_SCHED;
            PG8_LDB(B1, 1, 1); PG8_STAGE(PG8_SB(1, 0), b3, voffB);
            PG8_BAR; PG8_WAIT_L(0); PG8_MMA(0, 1, At, B1); PG8_BAR;
            PG8_LDA(At, 1, 1); PG8_STAGE(PG8_SA(1, 0), a3, voffA);
            PG8_BAR; PG8_WAIT_L(0); PG8_MMA(1, 0, At, B0); PG8_BAR; PG8_SCHED;
            PG8_STAGE(PG8_SB(1, 1), b3 + hstepB, voffB);
            PG8_WAIT_V(6); PG8_BAR; PG8_MMA(1, 1, At, B1); PG8_BAR;
            }
        }
        if constexpr (ALIGN_EPI) { if (wr == 0) PG8_BAR; }
        if constexpr (!Epi::AFTER_DRAIN) { E(acc, cur, wr, wc, fr, fq); S.done(cur); }
        if (!has_next) break;
#pragma unroll
        for (int a = 0; a < 2; ++a)
#pragma unroll
            for (int b = 0; b < 2; ++b)
#pragma unroll
                for (int m = 0; m < 4; ++m)
#pragma unroll
                    for (int n = 0; n < 2; ++n) acc[a][b][m][n] = (f32x4){0.f, 0.f, 0.f, 0.f};
        cur = nxt; cA = nA; cB = nB; ++ui;
        if constexpr (ALIGN_EPI) { if (wr == 1) PG8_BAR; }
    }
    PG8_WAIT_V(0);
    if constexpr (!ALIGN_EPI) { if (wr == 0) PG8_BAR; }
    PG8_BAR;
    if constexpr (Epi::AFTER_DRAIN) { E.fused(acc, cur, wr, wc, fr, fq, lds, wid, lane); S.done(cur); }
#undef PG8_SA
#undef PG8_SB
#undef PG8_STAGE
#undef PG8_LDA
#undef PG8_LDB
#undef PG8_MMA
#undef PG8_WAIT_V
#undef PG8_WAIT_L
#undef PG8_BAR
#undef PG8_SCHED
}
}
#define PG8_SP2 true
#define PG8_ALIGN true
#include <hip/hip_bf16.h>
#include <cmath>
namespace attn_body {
using bf16=__hip_bfloat16;
using bf16x8=__attribute__((ext_vector_type(8)))short;
using s16x4=__attribute__((ext_vector_type(4)))short;
using f32x16=__attribute__((ext_vector_type(16)))float;
using u32x4=__attribute__((ext_vector_type(4)))unsigned;
constexpr int BATCH=8,NHEAD=16,SEQ=4096,D=64,DM=NHEAD*D;
constexpr int NW=8,QBLK=32,QB=QBLK*NW,KVBLK=64,NQB=SEQ/QB;
constexpr int ATTN_PITCH=DM, ATTN_UNIT_ROWS=QB;
__device__ __forceinline__ int crow(int r,int hi){return (r&3)+8*(r>>2)+4*hi;}
#define SBAR() __builtin_amdgcn_sched_barrier(0)
__device__ __forceinline__ void cmask(f32x16&p0,f32x16&p1,int jb,int qrel,int hi){
  const float NEG=-INFINITY; int kb=64*jb+4*hi;
  #pragma unroll
  for(int r=0;r<16;++r){int kv=kb+(r&3)+8*(r>>2); if(kv>qrel)p0[r]=NEG; if(kv+32>qrel)p1[r]=NEG;}
}

constexpr int NSLOT=3, SLOTB=8192;
constexpr int LDS_K=0, LDS_V=NSLOT*SLOTB, LDS_WS=2*NSLOT*SLOTB, LDS_OST=LDS_WS+NW*64*4, LDS_KB=LDS_OST+NW*4096, LDS_BYTES=LDS_KB+SEQ*4;
constexpr float C2=0.125f*1.4426950408889634f;
__device__ __forceinline__ void glds16(const void*gsrc,unsigned lds_dst){unsigned keep;
  asm volatile("s_mov_b32 %0, m0\n\ts_mov_b32 m0, %2\n\ts_nop 0\n\tglobal_load_lds_dwordx4 %1, off\n\ts_mov_b32 m0, %0":"=&s"(keep):"v"(gsrc),"s"(lds_dst):"memory");}
__device__ __forceinline__ float max3f(float a,float b,float c){float r;asm("v_max3_f32 %0, %1, %2, %3":"=v"(r):"v"(a),"v"(b),"v"(c));return r;}
__device__ __forceinline__ float max2f(float a,float b){float r;asm("v_max_f32_e32 %0, %1, %2":"=v"(r):"v"(a),"v"(b));return r;}
__device__ __forceinline__ float fadd_s(float a,float b){float r;asm("v_add_f32_e32 %0, %1, %2":"=v"(r):"v"(a),"v"(b));return r;}
__device__ __forceinline__ float fsub_s(float a,float b){float r;asm("v_sub_f32_e32 %0, %1, %2":"=v"(r):"v"(a),"v"(b));return r;}
typedef float f32x2_t __attribute__((ext_vector_type(2))); typedef __bf16 bf16x2_t __attribute__((ext_vector_type(2)));
__device__ __forceinline__ unsigned cvtpk_s(float lo,float hi){f32x2_t v={lo,hi};bf16x2_t b=__builtin_convertvector(v,bf16x2_t);return __builtin_bit_cast(unsigned,b);}
#define WAIT_BAR(N) asm volatile("s_waitcnt vmcnt(" #N ") lgkmcnt(0)\n\ts_barrier":::"memory")

__device__ __forceinline__ void qkt(f32x16&p0,f32x16&p1,const char*Kslot,const bf16x8*qr,const f32x16&negm,int r32,int hi){
  const char*kb=Kslot+hi*1024+r32*16;
  #pragma unroll
  for(int d0=0;d0<4;++d0){
    const bf16x8 b0=*reinterpret_cast<const bf16x8*>(kb+d0*2048);
    const bf16x8 b1=*reinterpret_cast<const bf16x8*>(kb+d0*2048+512);
    if(d0==0){p0=__builtin_amdgcn_mfma_f32_32x32x16_bf16(b0,qr[0],negm,0,0,0);p1=__builtin_amdgcn_mfma_f32_32x32x16_bf16(b1,qr[0],negm,0,0,0);}
    else{p0=__builtin_amdgcn_mfma_f32_32x32x16_bf16(b0,qr[d0],p0,0,0,0);p1=__builtin_amdgcn_mfma_f32_32x32x16_bf16(b1,qr[d0],p1,0,0,0);}}
}
typedef __attribute__((address_space(3))) const char* lds_cptr;
typedef short v4i16_t __attribute__((ext_vector_type(4)));
__device__ __forceinline__ void kload8(bf16x8*kf,lds_cptr kp){
  kf[0]=*(const __attribute__((address_space(3))) bf16x8*)(kp);      kf[1]=*(const __attribute__((address_space(3))) bf16x8*)(kp+512);
  kf[2]=*(const __attribute__((address_space(3))) bf16x8*)(kp+2048); kf[3]=*(const __attribute__((address_space(3))) bf16x8*)(kp+2560);
  kf[4]=*(const __attribute__((address_space(3))) bf16x8*)(kp+4096); kf[5]=*(const __attribute__((address_space(3))) bf16x8*)(kp+4608);
  kf[6]=*(const __attribute__((address_space(3))) bf16x8*)(kp+6144); kf[7]=*(const __attribute__((address_space(3))) bf16x8*)(kp+6656);
}
__device__ __forceinline__ void kload2(bf16x8*kf,lds_cptr kp,int j){ kf[2*j]=*(const __attribute__((address_space(3))) bf16x8*)(kp+j*2048); kf[2*j+1]=*(const __attribute__((address_space(3))) bf16x8*)(kp+j*2048+512); }
__device__ __forceinline__ s16x4 vtr(lds_cptr p){ return __builtin_bit_cast(s16x4,__builtin_amdgcn_ds_read_tr16_b64_v4i16((__attribute__((address_space(3))) v4i16_t*)p)); }
__device__ __forceinline__ float rowmax(const f32x16&p0,const f32x16&p1){
  float a=max3f(p0[0],p0[1],p1[0]),b=max3f(p0[2],p0[3],p1[1]);a=max3f(a,p1[2],p1[3]);
  #pragma unroll
  for(int r=4;r<16;r+=4){a=max3f(a,p0[r],p0[r+1]);b=max3f(b,p0[r+2],p0[r+3]);a=max3f(a,p1[r],p1[r+1]);b=max3f(b,p1[r+2],p1[r+3]);}
  const float m=max2f(a,b);
  auto rr=__builtin_amdgcn_permlane32_swap(__float_as_uint(m),__float_as_uint(m),false,false);
  return max2f(__uint_as_float(rr[0]),__uint_as_float(rr[1]));
}
__device__ __forceinline__ void pv(f32x16*o,int vb,bf16x8 pa0,bf16x8 pa1,bf16x8 pa2,bf16x8 pa3){
  #pragma unroll
  for(int d0=0;d0<2;++d0){s16x4 lo[4],hi[4];
    #pragma unroll
    for(int ks=0;ks<4;++ks){
      asm volatile("ds_read_b64_tr_b16 %0,%1 offset:%c2":"=&v"(lo[ks]):"v"(vb),"i"(d0*4096+ks*1024):"memory");
      asm volatile("ds_read_b64_tr_b16 %0,%1 offset:%c2":"=&v"(hi[ks]):"v"(vb),"i"(d0*4096+ks*1024+512):"memory");}
    asm volatile("s_waitcnt lgkmcnt(0)":::"memory");SBAR();
    #define PK(k) (bf16x8){lo[k][0],lo[k][1],lo[k][2],lo[k][3],hi[k][0],hi[k][1],hi[k][2],hi[k][3]}
    o[d0]=__builtin_amdgcn_mfma_f32_32x32x16_bf16(pa0,PK(0),o[d0],0,0,0);
    o[d0]=__builtin_amdgcn_mfma_f32_32x32x16_bf16(pa1,PK(1),o[d0],0,0,0);
    o[d0]=__builtin_amdgcn_mfma_f32_32x32x16_bf16(pa2,PK(2),o[d0],0,0,0);
    o[d0]=__builtin_amdgcn_mfma_f32_32x32x16_bf16(pa3,PK(3),o[d0],0,0,0);
    #undef PK
  }
}

#ifndef ATTN_STORE16
#define ATTN_STORE16(p,v) (*(u32x4*)(p)=(v))
#endif
typedef float f32x4_t __attribute__((ext_vector_type(4)));
__device__ __forceinline__ float bflo(unsigned v){return __uint_as_float(v<<16);} __device__ __forceinline__ float bfhi(unsigned v){return __uint_as_float(v&0xffff0000u);}
__device__ __forceinline__ unsigned gate2(unsigned ov,unsigned gv){ const float g0=bflo(gv),g1=bfhi(gv); const float s0=__builtin_amdgcn_rcpf(1.f+__builtin_amdgcn_exp2f(-1.4426950408889634f*g0)),s1=__builtin_amdgcn_rcpf(1.f+__builtin_amdgcn_exp2f(-1.4426950408889634f*g1)); return cvtpk_s(bflo(ov)*s0,bfhi(ov)*s1); }
template<int THRL> __device__ __forceinline__ void attn_unit(int b,int h,int qb,const bf16*Q,const bf16*__restrict__ K,const bf16*__restrict__ V,bf16*O,const bf16*__restrict__ Gt,const float*__restrict__ KBg,char*shm){
  int tid_a_=threadIdx.x; asm volatile("":"+v"(tid_a_)); const int tid=tid_a_,lane=tid&63,r32=lane&31,hi=lane>>5; const int wid=__builtin_amdgcn_readfirstlane(tid>>6);
  const long rowbase=(long)b*SEQ; const int q0=qb*QB;
  const bf16*Qw=Q+(rowbase+q0+wid*QBLK)*DM+h*D;
  const bf16*Kh=K+rowbase*DM+h*D,*Vh=V+rowbase*DM+h*D;
  const unsigned lds0=(unsigned)(uintptr_t)shm;
  float*wsf=(float*)(shm+LDS_WS)+wid*64;
  const bf16*ksrc=Kh+(long)lane*DM+wid*8;
  const bf16*vsrc=Vh+(long)(16*(wid&3)+(lane>>2))*DM+(wid>>2)*32+(lane&3)*8;
  const unsigned kdst=lds0+LDS_K+wid*1024, vdst=lds0+LDS_V+wid*1024;
  #define DMA_K(t,slot) glds16(ksrc+(long)(t)*KVBLK*DM,(unsigned)__builtin_amdgcn_readfirstlane(kdst+(slot)))
  #define DMA_V(t,slot) glds16(vsrc+(long)(t)*KVBLK*DM,(unsigned)__builtin_amdgcn_readfirstlane(vdst+(slot)))
  const int vb0=(int)(lds0+LDS_V)+((lane>>4)&1)*32+(lane&3)*8+(4*hi+((lane&15)>>2))*64;
  const char*Kbase=shm+LDS_K; bf16x8 kf[8];
  const lds_cptr shm3=(lds_cptr)shm; const lds_cptr kp0=shm3+LDS_K+hi*1024+r32*16; const lds_cptr vp0=shm3+LDS_V+((lane>>4)&1)*32+(lane&3)*8+(4*hi+((lane&15)>>2))*64;
  { const u32x4*src_=(const u32x4*)(KBg+((long)b*NHEAD+h)*SEQ); __attribute__((address_space(3))) u32x4*dst_=(__attribute__((address_space(3))) u32x4*)(shm3+LDS_KB);
    for(int i_=tid;i_<(q0+QB)/4;i_+=NW*64)dst_[i_]=src_[i_]; }
  #define KBIAS(P0,P1,t) do{ const __attribute__((address_space(3))) f32x4_t*kp_=(const __attribute__((address_space(3))) f32x4_t*)(shm3+LDS_KB+(t)*256+hi*16); \
    _Pragma("unroll") for(int g_=0;g_<4;++g_){ const f32x4_t b0_=kp_[2*g_],b1_=kp_[8+2*g_]; \
      P0[4*g_]+=b0_[0];P0[4*g_+1]+=b0_[1];P0[4*g_+2]+=b0_[2];P0[4*g_+3]+=b0_[3]; P1[4*g_]+=b1_[0];P1[4*g_+1]+=b1_[1];P1[4*g_+2]+=b1_[2];P1[4*g_+3]+=b1_[3]; } }while(0)
  const int NT=(q0+QB)/KVBLK;
  DMA_K(0,0);DMA_V(0,0);DMA_K(1,SLOTB);
  bf16x8 qr[4];
  #pragma unroll
  for(int d0=0;d0<4;++d0)qr[d0]=*reinterpret_cast<const bf16x8*>(&Qw[(long)r32*DM+d0*16+hi*8]);
  float mhat=0.f,l_reg=0.f;f32x16 o[2];o[0]=f32x16{};o[1]=f32x16{};f32x16 negm=f32x16{};asm volatile("":"+v"(negm));
  const int qrel=wid*QBLK+r32;
  #define CMASK(P0,P1,t) do{int jb_=(t)-(NT-4); if(jb_>=0)cmask(P0,P1,jb_,qrel,hi);}while(0)
  bool resc=false;
  #define START(P0,P1) do{ const float rm=rowmax(P0,P1); resc=false; \
    { const float dl=rm; mhat=fadd_s(mhat,dl); \
      _Pragma("unroll") for(int r=0;r<16;++r){P0[r]=fsub_s(P0[r],dl);P1[r]=fsub_s(P1[r],dl);} \
      _Pragma("unroll") for(int r=0;r<16;++r)negm[r]=-mhat; asm volatile("":"+v"(negm)); } \
    _Pragma("unroll") for(int r=0;r<16;++r)P0[r]=__builtin_amdgcn_exp2f(P0[r]); }while(0)
  #define RESC() do{ if(resc){ asm volatile("s_waitcnt lgkmcnt(0)":::"memory"); \
      _Pragma("unroll") for(int d_=0;d_<2;++d_) _Pragma("unroll") for(int r=0;r<16;++r)o[d_][r]*=wsf[crow(r,hi)]; } }while(0)
  f32x16 pA0,pA1,pB0,pB1;
  int sl_prev=0,sl_cur=0,sl_next=SLOTB;
  #define ROT() do{sl_prev=sl_cur;sl_cur=sl_next;sl_next=(sl_next==(NSLOT-1)*SLOTB)?0:sl_next+SLOTB;}while(0)
  DMA_K(2,2*SLOTB);
  WAIT_BAR(3);
  qkt(pA0,pA1,Kbase,qr,negm,r32,hi);asm volatile("s_nop 15\n\ts_nop 7":"+v"(pA0),"+v"(pA1));KBIAS(pA0,pA1,0);CMASK(pA0,pA1,0);
  START(pA0,pA1);
  _Pragma("unroll") for(int r=0;r<16;++r)pA1[r]=__builtin_amdgcn_exp2f(pA1[r]);
  WAIT_BAR(0);
  DMA_K(3,0);DMA_V(1,SLOTB);
  ROT();
  kload8(kf,kp0+sl_cur);
  WAIT_BAR(2);
  s16x4 vlo[8],vhi[8]; u32x4 pw0,pw1,pw2,pw3;
  #define PKW(P,B) cvtpk_s(P[B],P[B+1])
  #define PAF(k) __builtin_bit_cast(bf16x8,pw##k)
  #define VFR(i) (bf16x8){vlo[i][0],vlo[i][1],vlo[i][2],vlo[i][3],vhi[i][0],vhi[i][1],vhi[i][2],vhi[i][3]}
  #define PIN(x) asm volatile("":"+v"(x))
  #define MX3(a,b,c) __builtin_fmaxf(__builtin_fmaxf((a),(b)),(c))
  #define GAPA(MF,A0,A1,A2,A3,W0,W1,PW) do{ MF; sacc+=A0; sacc+=A1; sacc+=A2; sacc+=A3; PIN(sacc); W0; W1; PIN(PW); SBAR(); }while(0)
  #define EX(v) __builtin_amdgcn_exp2f(v)
  #define GAPB(MF,X,B) do{ MF; X[B]=EX(X[B]); X[B+1]=EX(X[B+1]); X[B+2]=EX(X[B+2]); X[B+3]=EX(X[B+3]); PIN(X); SBAR(); }while(0)
  #define VRD(i) do{ vlo[i]=vtr(vp_+(((i)>>2)*4096+((i)&3)*1024)); vhi[i]=vtr(vp_+(((i)>>2)*4096+((i)&3)*1024+512)); }while(0)
  #define KRD(G,j) do{ if(G){ kload2(kf,kp0+sl_next,j); SBAR(); } }while(0)
  #define STEP(C0,C1,P0,P1,t,GK,GV,GL) do{ SBAR(); \
    const lds_cptr vp_=vp0+sl_prev; \
    VRD(0); SBAR(); float sacc=(P0[0]+P0[1]); \
    GAPA(C0=__builtin_amdgcn_mfma_f32_32x32x16_bf16(kf[0],qr[0],negm,0,0,0), P0[2],P0[3],P0[4],P0[5],     pw0[0]=PKW(P0,0), pw0[1]=PKW(P0,2), pw0); \
    VRD(4); SBAR(); GAPA(C1=__builtin_amdgcn_mfma_f32_32x32x16_bf16(kf[1],qr[0],negm,0,0,0), P0[6],P0[7],P0[8],P0[9],     pw0[2]=PKW(P0,4), pw0[3]=PKW(P0,6), pw0); \
    VRD(1); SBAR(); GAPA(C0=__builtin_amdgcn_mfma_f32_32x32x16_bf16(kf[2],qr[1],C0,0,0,0),   P0[10],P0[11],P0[12],P0[13], pw1[0]=PKW(P0,8), pw1[1]=PKW(P0,10), pw1); \
    VRD(5); SBAR(); GAPA(C1=__builtin_amdgcn_mfma_f32_32x32x16_bf16(kf[3],qr[1],C1,0,0,0),   P0[14],P0[15],P1[0],P1[1],   pw1[2]=PKW(P0,12),pw1[3]=PKW(P0,14), pw1); \
    VRD(2); SBAR(); GAPA(C0=__builtin_amdgcn_mfma_f32_32x32x16_bf16(kf[4],qr[2],C0,0,0,0),   P1[2],P1[3],P1[4],P1[5],     pw2[0]=PKW(P1,0), pw2[1]=PKW(P1,2), pw2); \
    VRD(6); SBAR(); GAPA(C1=__builtin_amdgcn_mfma_f32_32x32x16_bf16(kf[5],qr[2],C1,0,0,0),   P1[6],P1[7],P1[8],P1[9],     pw2[2]=PKW(P1,4), pw2[3]=PKW(P1,6), pw2); \
    VRD(3); SBAR(); GAPA(C0=__builtin_amdgcn_mfma_f32_32x32x16_bf16(kf[6],qr[3],C0,0,0,0),   P1[10],P1[11],P1[12],P1[13], pw3[0]=PKW(P1,8), pw3[1]=PKW(P1,10), pw3); \
    VRD(7); SBAR(); GAPA(C1=__builtin_amdgcn_mfma_f32_32x32x16_bf16(kf[7],qr[3],C1,0,0,0),   P1[14],P1[15],0.f,0.f,       pw3[2]=PKW(P1,12),pw3[3]=PKW(P1,14), pw3); \
    l_reg+=sacc; \
    if(GK){DMA_K((t)+3,sl_cur);} if(GV){DMA_V((t)+1,sl_next);} \
    KBIAS(C0,C1,t); CMASK(C0,C1,t); \
    { float a=MX3(C0[0],C0[1],C1[0]),b=MX3(C0[2],C0[3],C1[1]); a=MX3(a,C1[2],C1[3]); \
      _Pragma("unroll") for(int r=4;r<16;r+=4){a=MX3(a,C0[r],C0[r+1]);b=MX3(b,C0[r+2],C0[r+3]);a=MX3(a,C1[r],C1[r+1]);b=MX3(b,C1[r+2],C1[r+3]);} \
      float rm=__builtin_fmaxf(a,b); { auto rr=__builtin_amdgcn_permlane32_swap(__float_as_uint(rm),__float_as_uint(rm),false,false); rm=__builtin_fmaxf(__uint_as_float(rr[0]),__uint_as_float(rr[1])); } \
      resc=false; \
      if(__builtin_expect(__any(rm>(float)THRL),0)){ const float dl=__builtin_fmaxf(rm,0.f); mhat+=dl; \
        _Pragma("unroll") for(int r=0;r<16;++r){C0[r]-=dl;C1[r]-=dl;} \
        _Pragma("unroll") for(int r=0;r<16;++r)negm[r]=-mhat; asm volatile("":"+v"(negm)); \
        const float f=__builtin_amdgcn_exp2f(-dl); l_reg*=f; if(hi==0)wsf[r32]=f; resc=true; } } \
    SBAR(); \
    GAPB(o[0]=__builtin_amdgcn_mfma_f32_32x32x16_bf16(PAF(0),VFR(0),o[0],0,0,0), C0,0); \
    GAPB(o[1]=__builtin_amdgcn_mfma_f32_32x32x16_bf16(PAF(0),VFR(4),o[1],0,0,0), C0,4); \
    KRD(GL,0); GAPB(o[0]=__builtin_amdgcn_mfma_f32_32x32x16_bf16(PAF(1),VFR(1),o[0],0,0,0), C0,8); \
    KRD(GL,1); GAPB(o[1]=__builtin_amdgcn_mfma_f32_32x32x16_bf16(PAF(1),VFR(5),o[1],0,0,0), C0,12); \
    KRD(GL,2); GAPB(o[0]=__builtin_amdgcn_mfma_f32_32x32x16_bf16(PAF(2),VFR(2),o[0],0,0,0), C1,0); \
    KRD(GL,3); GAPB(o[1]=__builtin_amdgcn_mfma_f32_32x32x16_bf16(PAF(2),VFR(6),o[1],0,0,0), C1,4); \
    GAPB(o[0]=__builtin_amdgcn_mfma_f32_32x32x16_bf16(PAF(3),VFR(3),o[0],0,0,0), C1,8); \
    GAPB(o[1]=__builtin_amdgcn_mfma_f32_32x32x16_bf16(PAF(3),VFR(7),o[1],0,0,0), C1,12); \
    }while(0)
  int t=1;
  #undef CMASK
  #define CMASK(P0,P1,t) do{}while(0)
  for(;t+5<NT;t+=2){
    STEP(pB0,pB1,pA0,pA1,t,true,true,true);     WAIT_BAR(2); RESC(); ROT();
    STEP(pA0,pA1,pB0,pB1,t+1,true,true,true);   WAIT_BAR(2); RESC(); ROT();
  }
  #undef CMASK
  #define CMASK(P0,P1,t) do{int jb_=(t)-(NT-4); if(jb_>=0)cmask(P0,P1,jb_,qrel,hi);}while(0)
  #define ENDW(tt) do{ if((tt)+3<NT){WAIT_BAR(2);} else if((tt)+2<NT){WAIT_BAR(1);} else {WAIT_BAR(0);} }while(0)
  for(;t+1<NT;t+=2){
    STEP(pB0,pB1,pA0,pA1,t,(t+3<NT),(t+1<NT),(t+1<NT));       ENDW(t);   RESC(); ROT();
    STEP(pA0,pA1,pB0,pB1,t+1,(t+4<NT),(t+2<NT),(t+2<NT));     ENDW(t+1); RESC(); ROT();
  }
  STEP(pB0,pB1,pA0,pA1,NT-1,false,false,false); RESC();
  { float sacc=pB0[0]+pB0[1]; _Pragma("unroll") for(int r=2;r<16;++r)sacc+=pB0[r]; _Pragma("unroll") for(int r=0;r<16;++r)sacc+=pB1[r]; l_reg+=sacc;
    pw0=(u32x4){PKW(pB0,0),PKW(pB0,2),PKW(pB0,4),PKW(pB0,6)};pw1=(u32x4){PKW(pB0,8),PKW(pB0,10),PKW(pB0,12),PKW(pB0,14)};pw2=(u32x4){PKW(pB1,0),PKW(pB1,2),PKW(pB1,4),PKW(pB1,6)};pw3=(u32x4){PKW(pB1,8),PKW(pB1,10),PKW(pB1,12),PKW(pB1,14)};
    SBAR(); pv(o,vb0+sl_cur,PAF(0),PAF(1),PAF(2),PAF(3)); }
  #undef PKW
  #undef PAF
  #undef VFR
  #undef PIN
  #undef MX3
  #undef GAPA
  #undef GAPB
  #undef EX
  #undef VRD
  #undef KRD
  #undef STEP
  #undef ENDW
  {auto rr=__builtin_amdgcn_permlane32_swap(__float_as_uint(l_reg),__float_as_uint(l_reg),false,false);l_reg=__uint_as_float(rr[0])+__uint_as_float(rr[1]);}
  if(hi==0)wsf[32+r32]=l_reg;asm volatile("s_waitcnt lgkmcnt(0)":::"memory");
  float rli[16];
  #pragma unroll
  for(int r=0;r<16;++r)rli[r]=__builtin_amdgcn_rcpf(wsf[32+crow(r,hi)]);
  bf16*Ow=O+(rowbase+q0+wid*QBLK)*DM+h*D; const bf16*Gw=Gt+(rowbase+q0+wid*QBLK)*DM+h*D;
  { bf16*stg=(bf16*)(shm+LDS_OST)+wid*2048;
    #pragma unroll
    for(int r=0;r<16;++r){const int orow=crow(r,hi);
      #pragma unroll
      for(int d0=0;d0<2;++d0)stg[orow*64+d0*32+r32]=__float2bfloat16(o[d0][r]*rli[r]);}
    asm volatile("s_waitcnt lgkmcnt(0)":::"memory");
    #pragma unroll
    for(int i=0;i<4;++i){const int row=i*8+(lane>>3),ch=lane&7; u32x4 v=*(const u32x4*)(stg+row*64+ch*8); const u32x4 gv=*(const u32x4*)(Gw+(long)row*DM+ch*8); v.x=gate2(v.x,gv.x);v.y=gate2(v.y,gv.y);v.z=gate2(v.z,gv.z);v.w=gate2(v.w,gv.w); ATTN_STORE16(Ow+(long)row*DM+ch*8,v);} }
  asm volatile("s_waitcnt lgkmcnt(0)\n\ts_barrier":::"memory");
  #undef KBIAS
  #undef DMA_K
  #undef DMA_V
  #undef CMASK
  #undef START
  #undef RESC
  #undef ROT
}
constexpr int ATTN_LDS_BYTES=LDS_BYTES;
struct AttnTensors { const bf16* Q; const bf16* K; const bf16* V; bf16* O; const bf16* G; const float* KB; };
struct AttnUnit { int bh; int qb; };
struct StaticOrder {
  int vcu;
  int G_;
  __device__ __forceinline__ explicit StaticOrder(int grid,int block):vcu((grid%8==0)?(block%8)*(grid/8)+block/8:block),G_(grid){}
  __device__ __forceinline__ bool next(int i,AttnUnit&u)const{ const int pu=vcu+(i>>1)*G_; if(pu>=BATCH*NHEAD*(NQB/2))return false; const int s=pu%(NQB/2); u.bh=pu/(NQB/2); u.qb=(i&1)?(NQB-1-s):s; return true; }
  __device__ __forceinline__ void a_ready(const AttnUnit&)const{}
  __device__ __forceinline__ void done(const AttnUnit&)const{}
};
template<class Sched,int THRL=8> __device__ __forceinline__ void attn_phase(char*lds,const AttnTensors&T,const Sched&S){
  AttnUnit u;
  for(int i=0;S.next(i,u);++i){ S.a_ready(u); attn_unit<THRL>(u.bh/NHEAD,u.bh%NHEAD,u.qb,T.Q,T.K,T.V,T.O,T.G,T.KB,lds); S.done(u); }
}
#undef SBAR
#undef WAIT_BAR
}
#define GAS __attribute__((address_space(1)))
#define LAS __attribute__((address_space(3)))
typedef unsigned short bf16;
typedef unsigned v4u __attribute__((ext_vector_type(4)));
typedef float f32x4 __attribute__((ext_vector_type(4)));
typedef short bf16x8 __attribute__((ext_vector_type(8)));
typedef GAS unsigned gu32;
typedef GAS unsigned long long gu64;
#define RLX_AGENT __ATOMIC_RELAXED, __HIP_MEMORY_SCOPE_AGENT
#define LDS_WAIT() asm volatile("s_waitcnt lgkmcnt(0)" ::: "memory")
#define VM_WAIT() asm volatile("s_waitcnt vmcnt(0)" ::: "memory")
__device__ __forceinline__ unsigned long long rt() { return __builtin_amdgcn_s_memrealtime(); }
__device__ __forceinline__ unsigned f2bf(float f) { unsigned u = __builtin_bit_cast(unsigned, f); return (u + 0x7fffu + ((u >> 16) & 1u)) >> 16; }
__device__ __forceinline__ unsigned pk2(float lo, float hi) { return f2bf(lo) | (f2bf(hi) << 16); }

#define XB_TMO      128
#define XB_XCNT(j)  (256  + 64 * (j))
#define XB_XSUB(j)  (1280 + 64 * (j))
#define XB_XGEN(j)  (2304 + 64 * (j))
#define XB_TOP      3328
#define XB_TOPGEN   3392
#define XCD_BAR_WORDS 3456
#define XB_SPIN_CAP (1u << 18)

__device__ __forceinline__ unsigned xb_ld(unsigned* p)              { return __hip_atomic_load(p, __ATOMIC_RELAXED, __HIP_MEMORY_SCOPE_AGENT); }
__device__ __forceinline__ unsigned xb_add(unsigned* p, unsigned v) { return __hip_atomic_fetch_add(p, v, __ATOMIC_RELAXED, __HIP_MEMORY_SCOPE_AGENT); }
__device__ __forceinline__ unsigned xb_xcc_id() { return (unsigned)__builtin_amdgcn_s_getreg((3 << 11) | 20) & 0xFu; }
#define XB_SPIN(cond, bar) do { unsigned _sp = 0; while (cond) { __builtin_amdgcn_s_sleep(1); \
    if ((++_sp & 255u) == 0u) { if (xb_ld(&(bar)[XB_TMO])) break; if (_sp > XB_SPIN_CAP) { atomicAdd(&(bar)[XB_TMO], 1u); break; } } } } while (0)

struct XcdBarrier {
    unsigned* bar; unsigned x;
    volatile LAS unsigned* st;
};

__device__ __forceinline__ XcdBarrier xcd_barrier_post(unsigned* bar, volatile LAS unsigned* st) {
    XcdBarrier b; b.bar = bar; b.x = xb_xcc_id(); b.st = st;
    if (threadIdx.x == 0) (void)xb_add(&bar[XB_XCNT(b.x)], 1u);
    return b;
}
__device__ __forceinline__ void xcd_barrier_complete(unsigned* bar, unsigned x, unsigned& nloc, unsigned& nx) {
    const unsigned G = gridDim.x * gridDim.y * gridDim.z;
    unsigned sum, cnt, mine, sp = 0u;
    for (;;) {
        sum = 0u; cnt = 0u; mine = 0u;
#pragma unroll
        for (unsigned j = 0; j < 16; ++j) { const unsigned c = xb_ld(&bar[XB_XCNT(j)]); sum += c; cnt += (c > 0u) ? 1u : 0u; mine = (j == x) ? c : mine; }
        if (sum == G) break;
        __builtin_amdgcn_s_sleep(1);
        if ((++sp & 255u) == 0u) { if (xb_ld(&bar[XB_TMO])) break; if (sp > XB_SPIN_CAP) { atomicAdd(&bar[XB_TMO], 1u); break; } }
    }
    nloc = mine > 0u ? mine : 1u; nx = cnt > 0u ? cnt : 1u;
}

__device__ __forceinline__ void xcd_barrier(const XcdBarrier& b) {
    asm volatile("s_waitcnt vmcnt(0)" ::: "memory");
    __syncthreads();
    if (threadIdx.x == 0) {
        unsigned* bar = b.bar;
        __builtin_amdgcn_s_waitcnt(0);
        unsigned nloc = b.st[0], nx = b.st[1];
        if (nloc == 0u) { xcd_barrier_complete(bar, b.x, nloc, nx); b.st[0] = nloc; b.st[1] = nx; }
        const unsigned old = xb_add(&bar[XB_XSUB(b.x)], 1u);
        const unsigned gen = old / nloc;
        if (old + 1u == (gen + 1u) * nloc) {
            __builtin_amdgcn_fence(__ATOMIC_RELEASE, "agent");
            asm volatile("s_waitcnt vmcnt(0)" ::: "memory");
            const unsigned og = xb_add(&bar[XB_TOP], 1u);
            const unsigned tg = og / nx;
            if (og + 1u == (tg + 1u) * nx) xb_add(&bar[XB_TOPGEN], 1u);
            else XB_SPIN(xb_ld(&bar[XB_TOPGEN]) == tg, bar);
            __builtin_amdgcn_fence(__ATOMIC_ACQUIRE, "agent");
            xb_add(&bar[XB_XGEN(b.x)], 1u);
            asm volatile("s_waitcnt vmcnt(0)" ::: "memory");
        } else {
            XB_SPIN(xb_ld(&bar[XB_XGEN(b.x)]) == gen, bar);
            __builtin_amdgcn_fence(__ATOMIC_ACQUIRE, "agent");
            asm volatile("s_waitcnt vmcnt(0)" ::: "memory");
        }
    }
    __syncthreads();
}
namespace cg = cooperative_groups;
constexpr int NWAVES = 8;
constexpr int BATCH = 8, SEQ = 4096, D = 1024, FF = 4096, M = BATCH * SEQ;
constexpr int N0 = 2816;
constexpr int N1 = 4352;
constexpr int EVEN_IN = 2576, ODD_IN = 4112;
constexpr float LN_EPS = 1e-5f;
constexpr size_t MiB = 1u << 20;
constexpr size_t WS_CTL = 0, CTL_ZERO_BYTES = 1 * MiB;
constexpr size_t WS_MOD = 1 * MiB, WS_BIAS0 = 1 * MiB + 512 * 1024;
constexpr size_t WS_WIN0 = 2 * MiB, WS_WOUT0 = 8 * MiB, WS_W1_0 = 10 * MiB, WS_W2_0 = 18 * MiB, WS_WIN1 = 26 * MiB, WS_WOUT1 = 35 * MiB, WS_W1_1 = 37 * MiB, WS_W2_1 = 45 * MiB;
constexpr size_t WS_RGP = 54 * MiB, WS_RGH = 56 * MiB, WS_RGC = 58 * MiB, WS_GDEC = 60 * MiB, WS_RGWT = 60 * MiB + 512 * 1024, WS_FL = 61 * MiB, WS_KB = 63 * MiB;
constexpr size_t WS_U = 66 * MiB, WS_MIX = 130 * MiB, WS_PROJ = 194 * MiB, WS_GKV = 370 * MiB, WS_END = 450 * MiB;
constexpr size_t QKVG_STRIDE = 64 * MiB / 2;
constexpr int CW_BAR = 4096;
constexpr int RING_BYTES = 131072, LDSCTL_OFF = RING_BYTES, MISC_OFF = LDSCTL_OFF + 320, LDS_BYTES = 147456;
static_assert(attn_body::ATTN_LDS_BYTES <= RING_BYTES, "attention LDS");

struct Frame {
    LAS unsigned char* lds; volatile LAS unsigned* MISC; gu32* ctl;
    int vcu, G;
    unsigned char* ws;
};
__device__ __forceinline__ const float* inp(int i) { const __attribute__((address_space(4))) unsigned long long* k = (const __attribute__((address_space(4))) unsigned long long*)__builtin_amdgcn_kernarg_segment_ptr(); asm volatile("" : "+s"(k)); return (const float*)(const __attribute__((address_space(1))) float*)k[i]; }
#define WSP(T, off) ((T*)(F.ws + (off)))
#define PHASE_IDS int tid_ = threadIdx.x; asm volatile("" : "+v"(tid_)); const int tid = tid_, lane = tid & 63, wave = __builtin_amdgcn_readfirstlane(tid >> 6); (void)lane; (void)wave;
__device__ __forceinline__ float bf2f(bf16 v) { return __uint_as_float((unsigned)v << 16); }
__device__ __forceinline__ float sigmoid_f(float x) { return 1.f / (1.f + __expf(-x)); }
__device__ __forceinline__ float logsigmoid_f(float x) { return fminf(x, 0.f) - log1pf(expf(-fabsf(x))); }
__device__ __forceinline__ float gelu_tanh_f(float x) { return 0.5f * x * (1.f + tanhf(0.7978845608028654f * (x + 0.044715f * x * x * x))); }
__device__ __forceinline__ float wave_sum(float v) {
#pragma unroll
    for (int o = 1; o < 64; o <<= 1) v += __shfl_xor(v, o);
    return v;
}
__device__ __forceinline__ void p0_write_tile(bf16* WT, int K, int row0, int k0, LAS float* scr, int lane) {
    const int c = lane & 7;
#pragma unroll
    for (int j = 0; j < 4; ++j) { const int n = (lane >> 3) + 8 * j; const LAS float* s = scr + (8 * c) * 33 + n;
        v4u o; o.x = pk2(s[0 * 33], s[1 * 33]); o.y = pk2(s[2 * 33], s[3 * 33]); o.z = pk2(s[4 * 33], s[5 * 33]); o.w = pk2(s[6 * 33], s[7 * 33]);
        *(GAS v4u*)(WT + (size_t)(row0 + n) * K + k0 + 8 * c) = o; }
    LDS_WAIT(); asm volatile("" ::: "memory");
}
__device__ __forceinline__ void p0_transpose_item(const float* W, int ldw, int ncols, int K, int nblk, bf16* WT, int row_off, LAS float* scr, int item, int lane) {
    const int kb = item / nblk, nb = item % nblk, k0 = 64 * kb, n0 = 32 * nb; const int n = n0 + (lane & 31);
#pragma unroll 8
    for (int i = 0; i < 32; ++i) { const int kk = 2 * i + (lane >> 5); scr[kk * 33 + (lane & 31)] = (n < ncols) ? W[(size_t)(k0 + kk) * ldw + n] : 0.f; }
    LDS_WAIT(); asm volatile("" ::: "memory");
    p0_write_tile(WT, K, row_off + n0, k0, scr, lane);
}
__device__ __forceinline__ void p0_zup_item(const float* Win, const float* wup, bf16* WT, LAS float* scr, int item, int lane) {
    const int kb = item >> 3, jb = item & 7, k = 64 * kb + lane;
    f32x4 z[4];
#pragma unroll
    for (int q = 0; q < 4; ++q) z[q] = *(const f32x4*)(Win + (size_t)k * EVEN_IN + 2560 + 4 * q);
#pragma unroll 4
    for (int jj = 0; jj < 32; ++jj) { float acc = 0.f;
#pragma unroll
        for (int r = 0; r < 16; ++r) acc += z[r >> 2][r & 3] * wup[r * 256 + 32 * jb + jj];
        scr[lane * 33 + jj] = acc; }
    LDS_WAIT(); asm volatile("" ::: "memory");
    p0_write_tile(WT, D, 2560 + 32 * jb, 64 * kb, scr, lane);
}
__device__ __forceinline__ void p0a_phase(Frame& F) {
    PHASE_IDS
    if (F.vcu < 192) {
        LAS float* sc = (LAS float*)F.lds; LAS float* red = (LAS float*)(F.lds + 32768);
        for (int i = tid; i < BATCH * D; i += NWAVES * 64) { const float cv = inp(1)[i]; sc[i] = cv / (1.f + expf(-cv)); }
        __syncthreads();
        for (int item = F.vcu; item < 192; item += F.G) {
            const int ls = item / 48, cb = item % 48, col = cb * 64 + lane; const float* w = inp(2) + (size_t)ls * D * 3072 + col;
            float acc[8];
#pragma unroll
            for (int b = 0; b < 8; ++b) acc[b] = 0.f;
#pragma unroll 4
            for (int kk = 0; kk < 128; ++kk) { const int k = wave * 128 + kk; const float wv = w[(size_t)k * 3072];
#pragma unroll
                for (int b = 0; b < 8; ++b) acc[b] += sc[b * D + k] * wv; }
#pragma unroll
            for (int b = 0; b < 8; ++b) red[(wave * 8 + b) * 64 + lane] = acc[b];
            __syncthreads();
            { const int b = tid >> 6, l = tid & 63; float s = inp(3)[ls * 3072 + cb * 64 + l];
#pragma unroll
              for (int w8 = 0; w8 < 8; ++w8) s += red[(w8 * 8 + b) * 64 + l];
              WSP(float, WS_MOD)[(size_t)(ls * 8 + b) * 3072 + cb * 64 + l] = s; }
            __syncthreads();
        }
    }
    __syncthreads();
    LAS float* scr = (LAS float*)(F.lds + 49152 + wave * 8448);
    const int gw = F.vcu * NWAVES + wave, NGW = F.G * NWAVES;
    constexpr int I_IN0 = 16 * 80, I_ZUP = 128, I_OUT = 16 * 32, I_W1 = 16 * 128, I_W2 = 64 * 32, I_IN1 = 16 * 129;
    constexpr int NITEMS = I_IN0 + I_ZUP + 2 * I_OUT + 2 * I_W1 + 2 * I_W2 + I_IN1;
    for (int it = gw; it < NITEMS; it += NGW) {
        int r = it;
        if (r < I_IN0) { p0_transpose_item(inp(6), EVEN_IN, 2560, D, 80, WSP(bf16, WS_WIN0), 0, scr, r, lane); continue; } r -= I_IN0;
        if (r < I_ZUP) { p0_zup_item(inp(6), inp(14), WSP(bf16, WS_WIN0), scr, r, lane); continue; } r -= I_ZUP;
        if (r < I_OUT) { p0_transpose_item(inp(17), D, D, D, 32, WSP(bf16, WS_WOUT0), 0, scr, r, lane); continue; } r -= I_OUT;
        if (r < I_OUT) { p0_transpose_item(inp(22), D, D, D, 32, WSP(bf16, WS_WOUT1), 0, scr, r, lane); continue; } r -= I_OUT;
        if (r < I_W1) { p0_transpose_item(inp(23), FF, FF, D, 128, WSP(bf16, WS_W1_0), 0, scr, r, lane); continue; } r -= I_W1;
        if (r < I_W1) { p0_transpose_item(inp(23) + (size_t)D * FF, FF, FF, D, 128, WSP(bf16, WS_W1_1), 0, scr, r, lane); continue; } r -= I_W1;
        if (r < I_W2) { p0_transpose_item(inp(25), D, D, FF, 32, WSP(bf16, WS_W2_0), 0, scr, r, lane); continue; } r -= I_W2;
        if (r < I_W2) { p0_transpose_item(inp(25) + (size_t)FF * D, D, D, FF, 32, WSP(bf16, WS_W2_1), 0, scr, r, lane); continue; } r -= I_W2;
        p0_transpose_item(inp(18), ODD_IN, ODD_IN, D, 129, WSP(bf16, WS_WIN1), 0, scr, r, lane);
    }
    { const int gt = F.vcu * NWAVES * 64 + tid, NGT = F.G * NWAVES * 64; v4u* z = (v4u*)(WSP(bf16, WS_WIN1) + (size_t)4128 * D);
      for (int i = gt; i < (N1 - 4128) * D * 2 / 16; i += NGT) z[i] = (v4u){0u, 0u, 0u, 0u};
      for (int i = gt; i < N0; i += NGT) WSP(float, WS_BIAS0)[i] = (i < 2560) ? 0.f : inp(15)[i - 2560];
      for (int i = gt; i < 2 * 8 * 64 * 64; i += NGT) { const int k = i & 63, j = (i >> 6) & 63, n = (i >> 12) & 7, g = i >> 15; WSP(bf16, WS_RGWT)[i] = (bf16)f2bf((g ? inp(11) : inp(9))[(n * 64 + k) * 64 + j]); } }
}
__device__ __forceinline__ void modulate_phase(Frame& F, const float* x, const float* mod  , bf16* U) {
    PHASE_IDS
    const int gw = F.vcu * NWAVES + wave, NGW = F.G * NWAVES;
    for (int m = gw; m < M; m += NGW) {
        const GAS f32x4* xr = (const GAS f32x4*)(x + (size_t)m * D) + lane; const float* md = mod + (size_t)(m / SEQ) * 3072;
        GAS unsigned long long* o8 = (GAS unsigned long long*)(U + (size_t)m * D) + lane;
#pragma unroll
        for (int j = 0; j < 4; ++j) { const f32x4 v = xr[64 * j]; const f32x4 sh = *(const f32x4*)(md + 4 * lane + 256 * j), scl = *(const f32x4*)(md + D + 4 * lane + 256 * j);
            const f32x4 u = v * (scl + 1.0f) + sh; o8[64 * j] = (unsigned long long)pk2(u.x, u.y) | ((unsigned long long)pk2(u.z, u.w) << 32); }
    }
}
template <bool HAS_NEXT> __device__ __forceinline__ void ln_phase(Frame& F, float* xbuf, const float* g, const float* bb, const float* modn, bf16* U) {
    PHASE_IDS
    const int gw = F.vcu * NWAVES + wave, NGW = F.G * NWAVES;
    for (int m = gw; m < M; m += NGW) {
        GAS f32x4* xr = (GAS f32x4*)(xbuf + (size_t)m * D) + lane;
        f32x4 v[4]; float s = 0.f;
#pragma unroll
        for (int j = 0; j < 4; ++j) { v[j] = xr[64 * j]; s += (v[j].x + v[j].y) + (v[j].z + v[j].w); }
        const float mean = wave_sum(s) * (1.f / D); float s2 = 0.f;
#pragma unroll
        for (int j = 0; j < 4; ++j) { v[j] = v[j] - mean; s2 += (v[j].x * v[j].x + v[j].y * v[j].y) + (v[j].z * v[j].z + v[j].w * v[j].w); }
        const float rstd = 1.f / sqrtf(wave_sum(s2) * (1.f / D) + LN_EPS);
        const float* md = HAS_NEXT ? modn + (size_t)(m / SEQ) * 3072 : nullptr;
        GAS unsigned long long* o8 = (GAS unsigned long long*)(U + (size_t)m * D) + lane;
#pragma unroll
        for (int j = 0; j < 4; ++j) { const int col = 4 * lane + 256 * j; const f32x4 y = v[j] * rstd * *(const f32x4*)(g + col) + *(const f32x4*)(bb + col);
            xr[64 * j] = y;
            if (HAS_NEXT) { const f32x4 u = y * (*(const f32x4*)(md + D + col) + 1.0f) + *(const f32x4*)(md + col); o8[64 * j] = (unsigned long long)pk2(u.x, u.y) | ((unsigned long long)pk2(u.z, u.w) << 32); } }
    }
}
typedef float f32x16 __attribute__((ext_vector_type(16)));
#define MFMA32(a, b, c) __builtin_amdgcn_mfma_f32_32x32x16_bf16((a), (b), (c), 0, 0, 0)
__device__ __forceinline__ bf16x8 ldfrag(const LAS bf16* base, int stride, int row, int k) { return *(const LAS bf16x8*)(base + row * stride + k); }
__device__ __forceinline__ int crow(int reg, int hi) { return (reg & 3) + 8 * (reg >> 2) + 4 * hi; }
__device__ __forceinline__ v4u pack8(const float* f) { v4u o; o.x = pk2(f[0], f[1]); o.y = pk2(f[2], f[3]); o.z = pk2(f[4], f[5]); o.w = pk2(f[6], f[7]); return o; }
__device__ __forceinline__ float fsigmoid(float x) { return __builtin_amdgcn_rcpf(1.f + __expf(-x)); }
constexpr int RG_CH = 128, RG_NCH = SEQ / RG_CH;
template <bool FINAL> __device__ __forceinline__ void rg_pass(Frame& F) {
    PHASE_IDS
    const int r = lane & 31, hh = lane >> 5;
    LAS bf16* XT = (LAS bf16*)(F.lds + wave * 9216);
    const int gw = F.vcu * NWAVES + wave, NGW = F.G * NWAVES;
    const bf16* PROJ = WSP(bf16, WS_PROJ); const bf16* RGWT = WSP(bf16, WS_RGWT);
    for (int wu = gw; wu < BATCH * 8 * 2 * RG_NCH; wu += NGW) {
        const int ct = wu & 1, n = (wu >> 1) & 7, ch = (wu >> 4) & (RG_NCH - 1), b = wu >> 9;
        const int c = n * 64 + 32 * ct + r, cc = n * 64 + lane;
        bf16x8 bwa[4], bwx[4], idn[4];
#pragma unroll
        for (int ks = 0; ks < 4; ++ks) { bwa[ks] = *(const bf16x8*)(RGWT + ((size_t)(0 * 8 + n) * 64 + 32 * ct + r) * 64 + 16 * ks + 8 * hh); bwx[ks] = *(const bf16x8*)(RGWT + ((size_t)(1 * 8 + n) * 64 + 32 * ct + r) * 64 + 16 * ks + 8 * hh);
            const int m = 32 * ct + r - 16 * ks - 8 * hh;
#pragma unroll
            for (int jj = 0; jj < 8; ++jj) idn[ks][jj] = (m == jj) ? (short)0x3F80 : (short)0; }
        const float ba = inp(10)[c], bx = inp(12)[c], lsl8 = 8.0f * logsigmoid_f(inp(13)[c]);
        const float cw0 = inp(7)[cc], cw1 = inp(7)[512 + cc], cw2 = inp(7)[1024 + cc], cw3 = inp(7)[1536 + cc], cbv = inp(8)[cc];
        float h = FINAL ? WSP(float, WS_RGC)[(size_t)(b * RG_NCH + ch) * 512 + c] : 0.f, P = 1.f;
#pragma unroll 1
        for (int half = 0; half < 2; ++half) {
            const int tb = ch * RG_CH + 64 * half; const size_t row0 = (size_t)b * SEQ + tb;
            { const bf16* xr = PROJ + row0 * N0 + cc; float x0 = 0.f, x1 = 0.f, x2 = 0.f;
              if (tb > 0) { x0 = bf2f(xr[-3 * N0]); x1 = bf2f(xr[-2 * N0]); x2 = bf2f(xr[-1 * N0]); }
#pragma unroll 8
              for (int t = 0; t < 64; ++t) { const float x3 = bf2f(xr[(size_t)t * N0]); XT[t * 72 + lane] = (bf16)f2bf(cbv + cw0 * x0 + cw1 * x1 + cw2 * x2 + cw3 * x3); x0 = x1; x1 = x2; x2 = x3; } }
            asm volatile("s_waitcnt lgkmcnt(0)" ::: "memory");
#pragma unroll 1
            for (int tile = 0; tile < 2; ++tile) {
                const size_t trow = row0 + 32 * tile;
                float yv[16];
                if (FINAL) {
#pragma unroll
                    for (int q = 0; q < 16; ++q) yv[q] = bf2f(PROJ[(trow + crow(q, hh)) * N0 + 512 + c]); }
                f32x16 aa = {}, uu = {}, xi = {};
#pragma unroll
                for (int ks = 0; ks < 4; ++ks) { const bf16x8 af = ldfrag(XT, 72, 32 * tile + r, 16 * ks + 8 * hh); aa = MFMA32(af, bwa[ks], aa); uu = MFMA32(af, bwx[ks], uu); xi = MFMA32(af, idn[ks], xi); }
#pragma unroll
                for (int q = 0; q < 16; ++q) { const float rg = fsigmoid(aa[q] + ba), ig = fsigmoid(uu[q] + bx); const float a = __expf(lsl8 * rg); aa[q] = a; uu[q] = sqrtf(fmaxf(1.f - a * a, 0.f)) * (ig * xi[q]); }
                float GA[4], GB[4], PA[4], PB[4];
#pragma unroll
                for (int g = 0; g < 4; ++g) { float A = aa[4 * g], Bv = uu[4 * g];
#pragma unroll
                    for (int e = 1; e < 4; ++e) { A *= aa[4 * g + e]; Bv = aa[4 * g + e] * Bv + uu[4 * g + e]; }
                    GA[g] = A; GB[g] = Bv; PA[g] = __shfl_xor(A, 32); PB[g] = __shfl_xor(Bv, 32); }
                float hs[4];
#pragma unroll
                for (int g = 0; g < 4; ++g) { if (hh == 0) { hs[g] = h; h = GA[g] * h + GB[g]; h = PA[g] * h + PB[g]; } else { h = PA[g] * h + PB[g]; hs[g] = h; h = GA[g] * h + GB[g]; }
                    if (!FINAL) P *= GA[g] * PA[g]; }
                if (FINAL) {
#pragma unroll
                    for (int g = 0; g < 4; ++g) { float hv = hs[g];
#pragma unroll
                        for (int e = 0; e < 4; ++e) { const int q = 4 * g + e; hv = aa[q] * hv + uu[q]; const float y = yv[q]; const float th = 1.f - 2.f * __builtin_amdgcn_rcpf(1.f + __expf(1.5957691216057308f * (y + 0.044715f * y * y * y)));
                            WSP(bf16, WS_MIX)[(trow + crow(q, hh)) * D + c] = (bf16)f2bf(hv * 0.5f * y * (1.f + th)); } } }
            }
            asm volatile("s_waitcnt lgkmcnt(0)" ::: "memory");
        }
        if (!FINAL && hh == 0) { WSP(float, WS_RGP)[(size_t)(b * RG_NCH + ch) * 512 + c] = P; WSP(float, WS_RGH)[(size_t)(b * RG_NCH + ch) * 512 + c] = h; }
    }
}
__device__ __forceinline__ void gla_pass_a(Frame& F) {
    PHASE_IDS
    const int r = lane & 31, hh = lane >> 5;
    LAS bf16* KET = (LAS bf16*)F.lds; LAS bf16* VT = (LAS bf16*)(F.lds + 9216); LAS float* ESUM = (LAS float*)(F.lds + 27648);
    const bf16* PROJ = WSP(bf16, WS_PROJ);
    for (int unit = F.vcu; unit < BATCH * 4 * 64; unit += F.G) {
        const int bh = unit >> 6, nch = unit & 63, b = bh >> 2, h = bh & 3; const size_t row0 = (size_t)b * SEQ + nch * 64;
        const int d = tid & 63, te = wave;
        float la[8], kk[8];
        { const bf16* p = PROJ + (row0 + 8 * te) * N0 + h * 64 + d;
#pragma unroll
          for (int i = 0; i < 8; ++i) { la[i] = logsigmoid_f(bf2f(p[(size_t)i * N0 + 2560])) * (1.f / 16.f); kk[i] = bf2f(p[(size_t)i * N0 + 1280]); }
#pragma unroll
          for (int i = 1; i < 8; ++i) la[i] += la[i - 1];
          ESUM[te * 64 + d] = la[7]; }
        { const int v = tid & 127, tq = tid >> 7; const bf16* p = PROJ + (row0 + 16 * tq) * N0 + 1536 + h * 128 + v; float vv[16];
#pragma unroll
          for (int i = 0; i < 16; ++i) vv[i] = bf2f(p[(size_t)i * N0]);
          *(LAS v4u*)(VT + v * 72 + 16 * tq) = pack8(vv); *(LAS v4u*)(VT + v * 72 + 16 * tq + 8) = pack8(vv + 8); }
        __syncthreads();
        { float pre = 0.f, bl = 0.f;
#pragma unroll
          for (int e = 0; e < 8; ++e) { const float sv = ESUM[e * 64 + d]; bl += sv; if (e < te) pre += sv; }
          float ke[8];
#pragma unroll
          for (int i = 0; i < 8; ++i) ke[i] = kk[i] * __expf(bl - (pre + la[i]));
          *(LAS v4u*)(KET + d * 72 + 8 * te) = pack8(ke);
          if (te == 0) WSP(float, WS_GDEC)[(size_t)unit * 64 + d] = __expf(bl); }
        __syncthreads();
        { const int tm = wave >> 2, tn = wave & 3; f32x16 acc = {};
#pragma unroll
          for (int ks = 0; ks < 4; ++ks) acc = MFMA32(ldfrag(KET, 72, 32 * tm + r, 16 * ks + 8 * hh), ldfrag(VT, 72, 32 * tn + r, 16 * ks + 8 * hh), acc);
          float* kvp = WSP(float, WS_GKV) + (size_t)unit * 8192 + 32 * tn + r;
#pragma unroll
          for (int q = 0; q < 16; ++q) kvp[(32 * tm + crow(q, hh)) * 128] = acc[q]; }
        __syncthreads();
    }
}
__device__ __forceinline__ void gla_pass_c(Frame& F) {
    PHASE_IDS
    const int r = lane & 31, hh = lane >> 5;
    LAS bf16* QD = (LAS bf16*)F.lds; LAS bf16* KD = (LAS bf16*)(F.lds + 9216); LAS bf16* ATT = (LAS bf16*)(F.lds + 18432); LAS bf16* VT = (LAS bf16*)(F.lds + 27648); LAS bf16* ST = (LAS bf16*)(F.lds + 46080);
    LAS bf16* GT = (LAS bf16*)(F.lds + 64512); LAS float* ESUM = (LAS float*)(F.lds + 81408); LAS float* PART = (LAS float*)(F.lds + 83456);
    const bf16* PROJ = WSP(bf16, WS_PROJ);
    for (int unit = F.vcu; unit < BATCH * 4 * 64; unit += F.G) {
        const int bh = unit >> 6, nch = unit & 63, b = bh >> 2, h = bh & 3; const size_t row0 = (size_t)b * SEQ + nch * 64;
        const int d = tid & 63, te = wave;
        float la[8], kk[8], qq[8];
        { const bf16* p = PROJ + (row0 + 8 * te) * N0 + h * 64 + d;
#pragma unroll
          for (int i = 0; i < 8; ++i) { la[i] = logsigmoid_f(bf2f(p[(size_t)i * N0 + 2560])) * (1.f / 16.f); kk[i] = bf2f(p[(size_t)i * N0 + 1280]); qq[i] = bf2f(p[(size_t)i * N0 + 1024]) * 0.125f; }
#pragma unroll
          for (int i = 1; i < 8; ++i) la[i] += la[i - 1];
          ESUM[te * 64 + d] = la[7]; }
        { const int v = tid & 127, tq = tid >> 7; const bf16* p = PROJ + (row0 + 16 * tq) * N0 + 1536 + h * 128 + v; float vv[16];
#pragma unroll
          for (int i = 0; i < 16; ++i) vv[i] = bf2f(p[(size_t)i * N0]);
          *(LAS v4u*)(VT + v * 72 + 16 * tq) = pack8(vv); *(LAS v4u*)(VT + v * 72 + 16 * tq + 8) = pack8(vv + 8);
          const float* sp = WSP(float, WS_GKV) + (size_t)unit * 8192 + (16 * tq) * 128 + v;
#pragma unroll
          for (int i = 0; i < 16; ++i) vv[i] = sp[i * 128];
          *(LAS v4u*)(ST + v * 72 + 16 * tq) = pack8(vv); *(LAS v4u*)(ST + v * 72 + 16 * tq + 8) = pack8(vv + 8); }
        { const int t = tid >> 3, vc = tid & 7; const v4u* gp = (const v4u*)(PROJ + (row0 + t) * N0 + 2048 + h * 128 + 16 * vc); const v4u g0 = gp[0], g1 = gp[1];
          LAS unsigned long long* dst = (LAS unsigned long long*)(GT + t * 132 + 16 * vc);
          dst[0] = (unsigned long long)g0.x | ((unsigned long long)g0.y << 32); dst[1] = (unsigned long long)g0.z | ((unsigned long long)g0.w << 32);
          dst[2] = (unsigned long long)g1.x | ((unsigned long long)g1.y << 32); dst[3] = (unsigned long long)g1.z | ((unsigned long long)g1.w << 32); }
        __syncthreads();
        { float pre = 0.f;
#pragma unroll
          for (int e = 0; e < 8; ++e) { const float sv = ESUM[e * 64 + d]; if (e < te) pre += sv; }
#pragma unroll
          for (int i = 0; i < 8; ++i) { const float bc = pre + la[i]; QD[(8 * te + i) * 72 + d] = (bf16)f2bf(qq[i] * __expf(bc)); KD[(8 * te + i) * 72 + d] = (bf16)f2bf(kk[i] * __expf(-bc)); } }
        __syncthreads();
        if (wave < 3) { const int tm = (wave + 1) >> 1, tn = wave >> 1;
          f32x16 acc = {};
#pragma unroll
          for (int ks = 0; ks < 4; ++ks) acc = MFMA32(ldfrag(QD, 72, 32 * tm + r, 16 * ks + 8 * hh), ldfrag(KD, 72, 32 * tn + r, 16 * ks + 8 * hh), acc);
#pragma unroll
          for (int q = 0; q < 16; ++q) { const int t = 32 * tm + crow(q, hh), s_ = 32 * tn + r; ATT[t * 72 + s_] = (bf16)f2bf((t >= s_) ? acc[q] : 0.f); } }
        __syncthreads();
        const int tm = wave >> 1, tn = wave & 1;
        f32x16 acc = {};
        if (tn == 0) {
#pragma unroll
            for (int ks = 0; ks < 2; ++ks) acc = MFMA32(ldfrag(VT, 72, 32 * tm + r, 16 * ks + 8 * hh), ldfrag(ATT, 72, r, 16 * ks + 8 * hh), acc);
        } else {
#pragma unroll
            for (int ks = 0; ks < 4; ++ks) acc = MFMA32(ldfrag(VT, 72, 32 * tm + r, 16 * ks + 8 * hh), ldfrag(ATT, 72, 32 + r, 16 * ks + 8 * hh), acc);
        }
#pragma unroll
        for (int ks = 0; ks < 4; ++ks) acc = MFMA32(ldfrag(ST, 72, 32 * tm + r, 16 * ks + 8 * hh), ldfrag(QD, 72, 32 * tn + r, 16 * ks + 8 * hh), acc);
        { float ssq = 0.f;
#pragma unroll
          for (int q = 0; q < 16; ++q) ssq += acc[q] * acc[q];
          ssq += __shfl_xor(ssq, 32); if (hh == 0) PART[tm * 64 + 32 * tn + r] = ssq; }
        __syncthreads();
        { const int t = 32 * tn + r; const float tot = (PART[t] + PART[64 + t]) + (PART[128 + t] + PART[192 + t]); const float ri = 1.f / sqrtf(tot * (1.f / 128.f) + 1e-6f);
          const float* gn = inp(16) + h * 128 + 32 * tm + 4 * hh;
#pragma unroll
          for (int g = 0; g < 4; ++g) { const f32x4 gv = *(const f32x4*)(gn + 8 * g);
#pragma unroll
              for (int e = 0; e < 4; ++e) { const int q = 4 * g + e, v = 32 * tm + crow(q, hh); const float gg = bf2f(GT[t * 132 + v]); GT[t * 132 + v] = (bf16)f2bf(acc[q] * ri * gv[e] * (gg * fsigmoid(gg))); } } }
        __syncthreads();
        { const int t = tid >> 3, vc = tid & 7; const LAS unsigned long long* src = (const LAS unsigned long long*)(GT + t * 132 + 16 * vc); const unsigned long long a0 = src[0], a1 = src[1], a2 = src[2], a3 = src[3];
          v4u* op = (v4u*)(WSP(bf16, WS_MIX) + (row0 + t) * D + 512 + h * 128 + 16 * vc);
          op[0] = (v4u){(unsigned)a0, (unsigned)(a0 >> 32), (unsigned)a1, (unsigned)(a1 >> 32)}; op[1] = (v4u){(unsigned)a2, (unsigned)(a2 >> 32), (unsigned)a3, (unsigned)(a3 >> 32)}; }
        __syncthreads();
    }
}
__device__ __forceinline__ void chunk_scan_phase(Frame& F) {
    PHASE_IDS
    const int gt = F.vcu * NWAVES * 64 + tid, NGT = F.G * NWAVES * 64;
    float* KV = WSP(float, WS_GKV); const float* DEC = WSP(float, WS_GDEC);
    for (int idx = gt; idx < 32 * 8192; idx += NGT) {
        const int bh = idx >> 13, r = idx & 8191, dk = r >> 7; float S = 0.f;
#pragma unroll 1
        for (int n0 = 0; n0 < 64; n0 += 8) { float kv[8], dc[8];
#pragma unroll
            for (int q = 0; q < 8; ++q) { kv[q] = KV[((size_t)(bh * 64 + n0 + q)) * 8192 + r]; dc[q] = DEC[(bh * 64 + n0 + q) * 64 + dk]; }
#pragma unroll
            for (int q = 0; q < 8; ++q) { KV[((size_t)(bh * 64 + n0 + q)) * 8192 + r] = S; S = dc[q] * S + kv[q]; } }
    }
    const float* P = WSP(float, WS_RGP); const float* H = WSP(float, WS_RGH); float* C = WSP(float, WS_RGC);
    for (int idx = gt; idx < BATCH * 512; idx += NGT) {
        const int b = idx >> 9, c = idx & 511; float h = 0.f;
#pragma unroll 1
        for (int n0 = 0; n0 < RG_NCH; n0 += 8) { float pv[8], hv[8];
#pragma unroll
            for (int q = 0; q < 8; ++q) { pv[q] = P[(size_t)(b * RG_NCH + n0 + q) * 512 + c]; hv[q] = H[(size_t)(b * RG_NCH + n0 + q) * 512 + c]; }
#pragma unroll
            for (int q = 0; q < 8; ++q) { C[(size_t)(b * RG_NCH + n0 + q) * 512 + c] = h; h = pv[q] * h + hv[q]; } }
    }
}
__device__ __forceinline__ void fcum_phase(Frame& F) {
    PHASE_IDS
    const int gw = F.vcu * NWAVES + wave, NGW = F.G * NWAVES;
    for (int u = gw; u < BATCH * 16; u += NGW) {
        const int b = u >> 4, h = u & 15; const float bf = inp(19)[h]; const float* fl = WSP(float, WS_FL) + ((size_t)b * SEQ + lane * 64) * 16 + h;
        float v[64]; float s = 0.f;
#pragma unroll
        for (int i = 0; i < 64; ++i) { v[i] = logsigmoid_f(fl[i * 16] + bf); s += v[i]; }
        float incl = s;
#pragma unroll
        for (int o = 1; o < 64; o <<= 1) { const float t = __shfl_up(incl, o); if (lane >= o) incl += t; }
        float run = incl - s; float* kb = WSP(float, WS_KB) + (size_t)u * SEQ + lane * 64;
#pragma unroll
        for (int i4 = 0; i4 < 16; ++i4) { f32x4 o;
#pragma unroll
            for (int e = 0; e < 4; ++e) { run += v[4 * i4 + e]; o[e] = -1.4426950408889634f * run; }
            *(f32x4*)(kb + 4 * i4) = o; }
    }
}
struct Args { const float* in[27]; float* out; unsigned char* ws; };
__global__ void __launch_bounds__(NWAVES * 64, 2) mega_fwd(Args args) {
    extern __shared__ __attribute__((aligned(16))) unsigned char lds[];
    Frame F;
    F.lds = (LAS unsigned char*)lds; F.MISC = (volatile LAS unsigned*)(F.lds + MISC_OFF);
    F.G = gridDim.x; { const int bx = blockIdx.x; F.vcu = (F.G % 8 == 0) ? (bx % 8) * (F.G / 8) + bx / 8 : bx; }
    F.ws = args.ws; F.ctl = (gu32*)(args.ws + WS_CTL);
    for (int u = threadIdx.x; u < (LDS_BYTES - LDSCTL_OFF) / 4; u += NWAVES * 64) ((LAS unsigned*)(F.lds + LDSCTL_OFF))[u] = 0u;
    __syncthreads();
    XcdBarrier bar = xcd_barrier_post((unsigned*)(F.ctl + CW_BAR), F.MISC + 8);
#ifdef PROBE_A0
    unsigned long long* const ts_ = (unsigned long long*)(F.ctl + 2048); int tsn_ = 0;
#define TS() do { if (blockIdx.x == 0 && threadIdx.x == 0) ts_[tsn_] = __builtin_amdgcn_s_memrealtime(); ++tsn_; } while (0)
#else
#define TS() do { } while (0)
#endif
    TS();
#define GRID_BAR() do { xcd_barrier(bar); TS(); } while (0)
#define MODP(l, s) (WSP(float, WS_MOD) + (size_t)((l) * 2 + (s)) * BATCH * 3072)
#define GEMM_MULTI(EpiT, E, Aop, Bop, Nn, Kk) do { pg8::Gemm g_{(const pg8::bf16_t*)(Aop), (const pg8::bf16_t*)(Bop), M, (Nn), (Kk)}; pg8::StaticOrder S_; S_.init(M, (Nn), F.G, (int)blockIdx.x); \
        pg8::gemm_phase<EpiT, pg8::StaticOrder, PG8_ALIGN, PG8_SP2>(F.lds, g_, S_, (E)); } while (0)

    p0a_phase(F);
    cg::this_grid().sync(); TS();
    modulate_phase(F, inp(0), MODP(0, 0), WSP(bf16, WS_U));
    GRID_BAR();
    { pg8::EpiBf16<0> E{(pg8::bf16_t*)WSP(bf16, WS_PROJ), N0, WSP(float, WS_BIAS0), 0, 0, 1.f}; GEMM_MULTI(pg8::EpiBf16<0>, E, WSP(bf16, WS_U), WSP(bf16, WS_WIN0), N0, D); }
    GRID_BAR();
    rg_pass<false>(F); __syncthreads(); gla_pass_a(F);
    GRID_BAR();
    chunk_scan_phase(F);
    GRID_BAR();
    rg_pass<true>(F); __syncthreads(); gla_pass_c(F);
    GRID_BAR();
    { pg8::EpiResid E{inp(0), ((float*)inp(27)), nullptr, MODP(0, 0)}; GEMM_MULTI(pg8::EpiResid, E, WSP(bf16, WS_MIX), WSP(bf16, WS_WOUT0), D, D); }
    GRID_BAR();
    ln_phase<true>(F, ((float*)inp(27)), inp(4), inp(5), MODP(0, 1), WSP(bf16, WS_U));
    GRID_BAR();
    { pg8::EpiBf16<2> E{(pg8::bf16_t*)WSP(bf16, WS_PROJ), FF, inp(24), 0, 0, 1.f}; GEMM_MULTI(pg8::EpiBf16<2>, E, WSP(bf16, WS_U), WSP(bf16, WS_W1_0), FF, D); }
    GRID_BAR();
    { pg8::EpiResid E{((float*)inp(27)), ((float*)inp(27)), inp(26), MODP(0, 1)}; GEMM_MULTI(pg8::EpiResid, E, WSP(bf16, WS_PROJ), WSP(bf16, WS_W2_0), D, FF); }
    GRID_BAR();
    ln_phase<true>(F, ((float*)inp(27)), inp(4) + D, inp(5) + D, MODP(1, 0), WSP(bf16, WS_U));
    GRID_BAR();
    { pg8::EpiQKVG E{(pg8::bf16_t*)WSP(bf16, WS_PROJ), QKVG_STRIDE, WSP(float, WS_FL), inp(20), inp(21), attn_body::C2}; GEMM_MULTI(pg8::EpiQKVG, E, WSP(bf16, WS_U), WSP(bf16, WS_WIN1), N1, D); }
    GRID_BAR();
    fcum_phase(F);
    GRID_BAR();
    { const attn_body::AttnTensors AT{(const attn_body::bf16*)WSP(bf16, WS_PROJ), (const attn_body::bf16*)(WSP(bf16, WS_PROJ) + QKVG_STRIDE), (const attn_body::bf16*)(WSP(bf16, WS_PROJ) + 2 * QKVG_STRIDE),
                                      (attn_body::bf16*)WSP(bf16, WS_PROJ), (const attn_body::bf16*)(WSP(bf16, WS_PROJ) + 3 * QKVG_STRIDE), WSP(float, WS_KB)};
      const attn_body::StaticOrder S((int)F.G, (int)blockIdx.x);
      attn_body::attn_phase<attn_body::StaticOrder>((char*)lds, AT, S); }
    GRID_BAR();
    { pg8::EpiResid E{((float*)inp(27)), ((float*)inp(27)), nullptr, MODP(1, 0)}; GEMM_MULTI(pg8::EpiResid, E, WSP(bf16, WS_PROJ), WSP(bf16, WS_WOUT1), D, D); }
    GRID_BAR();
    ln_phase<true>(F, ((float*)inp(27)), inp(4) + 2 * D, inp(5) + 2 * D, MODP(1, 1), WSP(bf16, WS_U));
    GRID_BAR();
    { pg8::EpiBf16<2> E{(pg8::bf16_t*)WSP(bf16, WS_PROJ), FF, inp(24) + FF, 0, 0, 1.f}; GEMM_MULTI(pg8::EpiBf16<2>, E, WSP(bf16, WS_U), WSP(bf16, WS_W1_1), FF, D); }
    GRID_BAR();
    { pg8::EpiResid E{((float*)inp(27)), ((float*)inp(27)), inp(26) + D, MODP(1, 1)}; GEMM_MULTI(pg8::EpiResid, E, WSP(bf16, WS_PROJ), WSP(bf16, WS_W2_1), D, FF); }
    GRID_BAR();
    ln_phase<false>(F, ((float*)inp(27)), inp(4) + 3 * D, inp(5) + 3 * D, nullptr, WSP(bf16, WS_U));
#ifdef PROBE_A0
    asm volatile("s_waitcnt vmcnt(0)" ::: "memory"); __syncthreads(); TS();
    if (blockIdx.x == 0) {
        __syncthreads();
        float* o = (float*)inp(27);
        const float ta = (float)(ts_[PROBE_A1] - ts_[PROBE_A0]) * 0.01f, tr = (float)(ts_[PROBE_R1] - ts_[PROBE_R0]) * 0.01f;
        const float dl = sqrtf(tr / 4000.f);
        for (int i = threadIdx.x; i < 8192; i += NWAVES * 64) o[i] += (i == 0) ? (ta / 64.f) : dl;
    }
#endif
}

extern "C" void kernel_launch(void* const* d_in, const int* in_sizes, int n_in, void* d_out, int out_size, void* d_ws, size_t ws_size, hipStream_t stream) {
    static int grid = 0;
    if (grid == 0) {
        if (n_in != 27 || in_sizes[0] != M * D || out_size != M * D || ws_size < WS_END) { fprintf(stderr, "kernel_launch: unexpected shapes (n_in %d, in0 %d, out %d, ws %zu); nothing launched\n", n_in, n_in > 0 ? in_sizes[0] : -1, out_size, ws_size); grid = -1; return; }
        int dev = 0, cus = 0, per_cu = 0;
        if (hipGetDevice(&dev) != hipSuccess || hipDeviceGetAttribute(&cus, hipDeviceAttributeMultiprocessorCount, dev) != hipSuccess) { grid = -1; return; }
        if (hipFuncSetAttribute((const void*)mega_fwd, hipFuncAttributeMaxDynamicSharedMemorySize, LDS_BYTES) != hipSuccess) { fprintf(stderr, "kernel_launch: hipFuncSetAttribute failed\n"); grid = -1; return; }
        if (hipOccupancyMaxActiveBlocksPerMultiprocessor(&per_cu, (const void*)mega_fwd, NWAVES * 64, LDS_BYTES) != hipSuccess || per_cu < 1) { fprintf(stderr, "kernel_launch: occupancy query says %d blocks per CU; nothing launched\n", per_cu); (void)hipGetLastError(); grid = -1; return; }
        grid = cus * per_cu;
    }
    if (grid < 0) return;
    if (hipMemsetAsync((char*)d_ws + WS_CTL, 0, CTL_ZERO_BYTES, stream) != hipSuccess) { fprintf(stderr, "kernel_launch: memset failed\n"); return; }
    Args a{};
    for (int i = 0; i < 27; ++i) a.in[i] = (const float*)d_in[i];
    a.out = (float*)d_out; a.ws = (unsigned char*)d_ws;
    void* kargs[] = {&a};
    const hipError_t e = hipLaunchCooperativeKernel((const void*)mega_fwd, dim3(grid), dim3(NWAVES * 64), kargs, LDS_BYTES, stream);
    if (e != hipSuccess) fprintf(stderr, "kernel_launch: cooperative launch failed: %s (grid %d)\n", hipGetErrorString(e), grid);
}
```

```cpp
#include <hip/hip_runtime.h>
#include <hip/hip_cooperative_groups.h>
#include <cstdio>
#include <cstdint>

namespace pg8 {
#define PG8_LAS __attribute__((address_space(3)))
typedef unsigned short bf16_t;
typedef short bf16x8 __attribute__((ext_vector_type(8)));
typedef float f32x4 __attribute__((ext_vector_type(4)));
typedef unsigned u32x4 __attribute__((ext_vector_type(4)));
constexpr int BM = 256, BK = 64, HALF = 128, HTB = HALF * BK * 2  , STAGE_BYTES = 8 * HTB, NXCD = 8, WGM = 8;

__host__ __device__ __forceinline__ int lds_byte(int r, int c) { const int st = (r >> 4) * 2 + (c >> 5), rr = r & 15, cc = c & 31, ob = rr * 64 + cc * 2; return st * 1024 + (ob ^ (((ob >> 9) & 1) << 5)); }
__host__ __device__ __forceinline__ void stage_rc(int b, int& R, int& C) { const int st = b / 1024, sb = b % 1024, swz = sb ^ (((sb >> 9) & 1) << 5); R = (st >> 1) * 16 + swz / 64; C = (st & 1) * 32 + (swz % 64) / 2; }
__host__ __device__ __forceinline__ int perm32(int rho) { const int n = rho >> 4, i = rho & 15; return 8 * (i >> 2) + 4 * n + (i & 3); }

struct Unit { int pm, pn; };
struct Gemm { const bf16_t* A; const bf16_t* Bt; int M, N, K; };

struct StaticOrder {
    int nM, nN, nwg, G, c;
    __host__ __device__ void init(int M, int N, int G_, int c_) { nM = M / BM; nN = N / BM; nwg = nM * nN; G = G_; c = c_; }
    __host__ __device__ bool next(int i, Unit& u) const {
        const long L = (long)i * G + c; if (L >= nwg) return false;
        int wgid = (int)L; { const int q = nwg / NXCD, r = nwg % NXCD, xcd = wgid % NXCD, off = wgid / NXCD; wgid = (xcd < r ? xcd * (q + 1) : r * (q + 1) + (xcd - r) * q) + off; }
        const int nig = WGM * nN, gid = wgid / nig, fm = gid * WGM, gsz = (nM - fm) < WGM ? (nM - fm) : WGM;
        u.pm = fm + ((wgid % nig) % gsz); u.pn = (wgid % nig) / gsz; return true;
    }
    __device__ __forceinline__ void a_ready(const Unit&) const {}
    __device__ __forceinline__ void done(const Unit&) const {}
};

__device__ __forceinline__ unsigned cvt_pk_bf16(float lo, float hi) { unsigned r; asm volatile("v_cvt_pk_bf16_f32 %0, %1, %2" : "=v"(r) : "v"(lo), "v"(hi)); return r; }
typedef float f32x2 __attribute__((ext_vector_type(2)));
__device__ __forceinline__ f32x2 gelu_pk(f32x2 v) {
    const f32x2 av = __builtin_elementwise_abs(v), d = av * 0.2316418882f + 1.0f;
    f32x2 t; t.x = __builtin_amdgcn_rcpf(d.x); t.y = __builtin_amdgcn_rcpf(d.y);
    f32x2 q = t * 0.5307027145f + (-0.7265760135f); q = q * t + 0.7107068705f; q = q * t + (-0.142248368f); q = q * t + 0.127414796f; q = q * t;
    const f32x2 s = (v * v) * (-0.72134752044f);
    f32x2 e; e.x = __builtin_amdgcn_exp2f(s.x); e.y = __builtin_amdgcn_exp2f(s.y);
    const f32x2 m = v * (q * e), r = v - m;
    f32x2 o; o.x = v.x < 0.f ? m.x : r.x; o.y = v.y < 0.f ? m.y : r.y; return o;
}

template <int ACT  > struct EpiBf16 {
    static constexpr bool PERM = true, AFTER_DRAIN = false, HEADPERM = false; static_assert(ACT == 0 || ACT == 1 || ACT == 2, "EpiBf16: ACT is 0 (none), 1 (gelu_pk) or 2 (relu^2)");
    bf16_t* O; int ldc; const float* bias; int split_cols; size_t split_stride; float scale0;
    __device__ __forceinline__ void operator()(const f32x4 (&acc)[2][2][4][2], const Unit& u, int wr, int wc, int fr, int fq) const {
        const int row0 = u.pm * BM + wr * 64 + fr; int colt = u.pn * BM; bf16_t* base = O;
        float sc = 1.f; if (split_cols) { const int t = colt / split_cols; base += (size_t)t * split_stride; colt -= t * split_cols; if (t == 0) sc = scale0; }
        const int col0 = colt + wc * 32 + 8 * fq, bcol0 = u.pn * BM + wc * 32 + 8 * fq;
        f32x4 bv[2][2];
#pragma unroll
        for (int bj = 0; bj < 2; ++bj)
#pragma unroll
            for (int n = 0; n < 2; ++n) bv[bj][n] = bias ? *(const f32x4*)(bias + bcol0 + bj * HALF + 4 * n) : (f32x4){0.f, 0.f, 0.f, 0.f};
#pragma unroll
        for (int ai = 0; ai < 2; ++ai)
#pragma unroll
            for (int m = 0; m < 4; ++m) { bf16_t* rowp = base + (size_t)(row0 + ai * HALF + m * 16) * ldc + col0;
#pragma unroll
                for (int bj = 0; bj < 2; ++bj) { f32x4 v0 = acc[ai][bj][m][0] + bv[bj][0], v1 = acc[ai][bj][m][1] + bv[bj][1];
                    if (ACT == 1) { f32x2 a = gelu_pk((f32x2){v0[0], v0[1]}), b = gelu_pk((f32x2){v0[2], v0[3]}), c = gelu_pk((f32x2){v1[0], v1[1]}), d = gelu_pk((f32x2){v1[2], v1[3]});
                        v0 = (f32x4){a.x, a.y, b.x, b.y}; v1 = (f32x4){c.x, c.y, d.x, d.y}; }
                    if (ACT == 2) { _Pragma("unroll") for (int e_ = 0; e_ < 4; ++e_) { const float a_ = fmaxf(v0[e_], 0.f), b_ = fmaxf(v1[e_], 0.f); v0[e_] = a_ * a_; v1[e_] = b_ * b_; } }
                    v0 = v0 * sc; v1 = v1 * sc; u32x4 w; w.x = cvt_pk_bf16(v0[0], v0[1]); w.y = cvt_pk_bf16(v0[2], v0[3]); w.z = cvt_pk_bf16(v1[0], v1[1]); w.w = cvt_pk_bf16(v1[2], v1[3]);
                    *(u32x4*)(rowp + bj * HALF) = w; } }
    }
};
typedef unsigned u32x2 __attribute__((ext_vector_type(2)));
struct EpiResid {
    static constexpr bool PERM = false, AFTER_DRAIN = false, HEADPERM = false;
    const float* base; float* out; const float* bias; const float* mod;
    __device__ __forceinline__ void operator()(const f32x4 (&acc)[2][2][4][2], const Unit& u, int wr, int wc, int fr, int fq) const {
        const int col0 = u.pn * BM + wc * 32 + 4 * fq; const float* mg = mod + (size_t)(u.pm >> 4) * 3072 + 2048;
        f32x4 gv[2][2], bv[2][2];
#pragma unroll
        for (int bj = 0; bj < 2; ++bj)
#pragma unroll
            for (int n = 0; n < 2; ++n) { gv[bj][n] = *(const f32x4*)(mg + col0 + bj * HALF + n * 16) + 1.0f; bv[bj][n] = bias ? *(const f32x4*)(bias + col0 + bj * HALF + n * 16) : (f32x4){0.f, 0.f, 0.f, 0.f}; }
#pragma unroll
        for (int ai = 0; ai < 2; ++ai)
#pragma unroll
            for (int m = 0; m < 4; ++m) { const size_t off = (size_t)(u.pm * BM + ai * HALF + wr * 64 + m * 16 + fr) * 1024 + col0;
#pragma unroll
                for (int bj = 0; bj < 2; ++bj)
#pragma unroll
                    for (int n = 0; n < 2; ++n) { const f32x4 bs = *(const f32x4*)(base + off + bj * HALF + n * 16);
                        *(f32x4*)(out + off + bj * HALF + n * 16) = bs * 1.41421356237309515f + gv[bj][n] * (acc[ai][bj][m][n] + bv[bj][n]); }
                if (m & 1) asm volatile("" ::: "memory"); }
    }
};
struct EpiQKVG {
    static constexpr bool PERM = true, AFTER_DRAIN = false, HEADPERM = true;
    bf16_t* qkvg; size_t stride; float* fl; const float* qg; const float* kg; float scale0;
    __device__ __forceinline__ void operator()(const f32x4 (&acc)[2][2][4][2], const Unit& u, int wr, int wc, int fr, int fq) const {
        const int row0 = u.pm * BM + wr * 64 + fr;
        if (u.pn == 16) {
            if (wc == 0 && fq < 2) {
#pragma unroll
                for (int ai = 0; ai < 2; ++ai)
#pragma unroll
                    for (int m = 0; m < 4; ++m) { float* p = fl + (size_t)(row0 + ai * HALF + m * 16) * 16 + 8 * fq; *(f32x4*)p = acc[ai][0][m][0]; *(f32x4*)(p + 4) = acc[ai][0][m][1]; }
            }
            return;
        }
        const int t = u.pn >> 2; bf16_t* dst = qkvg + (size_t)t * stride + (u.pn & 3) * 256 + wc * 64 + 8 * fq;
        f32x4 gv[2][2]; const float* gsrc = (t == 0) ? qg : kg; const float sc = (t == 0) ? scale0 : 1.0f;
        if (t < 2) {
#pragma unroll
            for (int bj = 0; bj < 2; ++bj)
#pragma unroll
                for (int n = 0; n < 2; ++n) gv[bj][n] = *(const f32x4*)(gsrc + 32 * bj + 8 * fq + 4 * n) * sc;
        }
#pragma unroll
        for (int ai = 0; ai < 2; ++ai)
#pragma unroll
            for (int m = 0; m < 4; ++m) { bf16_t* rowp = dst + (size_t)(row0 + ai * HALF + m * 16) * 1024;
                f32x4 v[2][2];
#pragma unroll
                for (int bj = 0; bj < 2; ++bj)
#pragma unroll
                    for (int n = 0; n < 2; ++n) v[bj][n] = acc[ai][bj][m][n];
                if (t < 2) { float ss = 0.f;
#pragma unroll
                    for (int bj = 0; bj < 2; ++bj)
#pragma unroll
                        for (int n = 0; n < 2; ++n) { const f32x4 x = v[bj][n]; ss += (x[0] * x[0] + x[1] * x[1]) + (x[2] * x[2] + x[3] * x[3]); }
                    ss += __shfl_xor(ss, 16); ss += __shfl_xor(ss, 32);
                    const float ri = 1.0f / sqrtf(ss * (1.0f / 64.0f) + 1e-6f);
#pragma unroll
                    for (int bj = 0; bj < 2; ++bj)
#pragma unroll
                        for (int n = 0; n < 2; ++n) v[bj][n] = v[bj][n] * ri * gv[bj][n]; }
#pragma unroll
                for (int bj = 0; bj < 2; ++bj) { u32x4 w; w.x = cvt_pk_bf16(v[bj][0][0], v[bj][0][1]); w.y = cvt_pk_bf16(v[bj][0][2], v[bj][0][3]); w.z = cvt_pk_bf16(v[bj][1][0], v[bj][1][1]); w.w = cvt_pk_bf16(v[bj][1][2], v[bj][1][3]);
                    *(u32x4*)(rowp + 32 * bj) = w; } }
    }
};

template <class Epi, class Sched, bool ALIGN_EPI = false, bool SP2 = false>
__device__ __forceinline__ void gemm_phase(PG8_LAS unsigned char* lds, const Gemm g, const Sched& S, const Epi& E) {
    int tid_g_ = threadIdx.x; asm volatile("" : "+v"(tid_g_)); const int tid = tid_g_, wid = __builtin_amdgcn_readfirstlane(tid >> 6), lane = tid & 63, wr = wid >> 2, wc = wid & 3, fr = lane & 15, fq = lane >> 4;
    const int K = g.K, nt = K / BK;
    unsigned voffA[2], voffB[2];
#pragma unroll
    for (int i = 0; i < 2; ++i) { int R, C; stage_rc(tid * 16 + i * 8192, R, C); const int Rb = Epi::HEADPERM ? (64 * (R >> 5) + perm32(R & 31)) : (Epi::PERM ? ((R & ~31) + perm32(R & 31)) : R);
        voffA[i] = (unsigned)(R * K + C) * 2u; voffB[i] = (unsigned)(Rb * K + C) * 2u; }
    const size_t kstep = (size_t)(BK * 2);
    const size_t hstep = (size_t)HALF * K * 2;
    const size_t tstep = 2 * hstep; const size_t hstepB = Epi::HEADPERM ? (size_t)32 * K * 2 : hstep;
    const unsigned ldsw = (unsigned)wid * 1024u;
    const int aoff = lds_byte(wr * 64 + fr, fq * 8), boff = lds_byte(wc * 32 + fr, fq * 8);
#define PG8_SA(b, h) (((b) * 2 + (h)) * HTB)
#define PG8_SB(b, h) ((4 + (b) * 2 + (h)) * HTB)
#define PG8_STAGE(bufoff, gbase, voff) do { _Pragma("unroll") for (int _i = 0; _i < 2; ++_i) \
        __builtin_amdgcn_global_load_lds((const unsigned*)((const char*)(gbase) + (voff)[_i]), (PG8_LAS unsigned*)(lds + (bufoff) + ldsw + _i * 8192), 16, 0, 0); } while (0)
#define PG8_LDA(dst, b, h) do { _Pragma("unroll") for (int m = 0; m < 4; ++m) _Pragma("unroll") for (int k = 0; k < 2; ++k) dst[m][k] = *(const PG8_LAS bf16x8*)(lds + PG8_SA(b, h) + aoff + m * 2048 + k * 1024); } while (0)
#define PG8_LDB(dst, b, h) do { _Pragma("unroll") for (int n = 0; n < 2; ++n) _Pragma("unroll") for (int k = 0; k < 2; ++k) dst[n][k] = *(const PG8_LAS bf16x8*)(lds + PG8_SB(b, h) + boff + n * 2048 + k * 1024); } while (0)
#define PG8_MMA(ai, bj, At, Bt) do { __builtin_amdgcn_s_setprio(1); _Pragma("unroll") for (int m = 0; m < 4; ++m) _Pragma("unroll") for (int n = 0; n < 2; ++n) _Pragma("unroll") for (int k = 0; k < 2; ++k) \
        acc[ai][bj][m][n] = __builtin_amdgcn_mfma_f32_16x16x32_bf16(Bt[n][k], At[m][k], acc[ai][bj][m][n], 0, 0, 0); __builtin_amdgcn_s_setprio(0); } while (0)
#define PG8_WAIT_V(n) asm volatile("s_waitcnt vmcnt(" #n ")" ::: "memory")
#define PG8_WAIT_L(n) asm volatile("s_waitcnt lgkmcnt(" #n ")" ::: "memory")
#define PG8_BAR __builtin_amdgcn_s_barrier()
#define PG8_SCHED __builtin_amdgcn_sched_barrier(0)
    Unit cur, nxt; int ui = 0;
    if (!S.next(0, cur)) return;
    f32x4 acc[2][2][4][2];
#pragma unroll
    for (int a = 0; a < 2; ++a)
#pragma unroll
        for (int b = 0; b < 2; ++b)
#pragma unroll
            for (int m = 0; m < 4; ++m)
#pragma unroll
                for (int n = 0; n < 2; ++n) acc[a][b][m][n] = (f32x4){0.f, 0.f, 0.f, 0.f};
    bf16x8 At[4][2], B0[2][2], B1[2][2];
    const char* cA = (const char*)g.A + (size_t)cur.pm * tstep; const char* cB = (const char*)g.Bt + (size_t)cur.pn * tstep;
    S.a_ready(cur);
    if constexpr (SP2) {
        PG8_STAGE(PG8_SB(0, 0), cB, voffB); PG8_STAGE(PG8_SB(0, 1), cB + hstepB, voffB); PG8_STAGE(PG8_SA(0, 0), cA, voffA); PG8_STAGE(PG8_SA(0, 1), cA + hstep, voffA);
        if (wr == 1) PG8_BAR;
        PG8_WAIT_V(2); PG8_BAR;
        PG8_STAGE(PG8_SB(1, 0), cB + kstep, voffB); PG8_STAGE(PG8_SA(1, 0), cA + kstep, voffA); PG8_STAGE(PG8_SB(1, 1), cB + hstepB + kstep, voffB);
        PG8_WAIT_V(6); PG8_BAR;
    } else {
        PG8_STAGE(PG8_SB(0, 0), cB, voffB); PG8_STAGE(PG8_SA(0, 0), cA, voffA); PG8_STAGE(PG8_SB(0, 1), cB + hstepB, voffB); PG8_STAGE(PG8_SA(0, 1), cA + hstep, voffA);
        if (wr == 1) PG8_BAR;
        PG8_WAIT_V(4); PG8_BAR;
        PG8_STAGE(PG8_SB(1, 0), cB + kstep, voffB); PG8_STAGE(PG8_SA(1, 0), cA + kstep, voffA); PG8_STAGE(PG8_SB(1, 1), cB + hstepB + kstep, voffB);
        PG8_WAIT_V(6); PG8_BAR;
    }
    for (;;) {
        const bool has_next = S.next(ui + 1, nxt);
        const char* nA = has_next ? (const char*)g.A + (size_t)nxt.pm * tstep : cA; const char* nB = has_next ? (const char*)g.Bt + (size_t)nxt.pn * tstep : cB;
        for (int t = 0; t < nt; t += 2) {
            const bool last = (t == nt - 2);
            const char* a1 = cA + (size_t)(t + 1) * kstep;
            const char* a2 = last ? nA : cA + (size_t)(t + 2) * kstep; const char* b2 = last ? nB : cB + (size_t)(t + 2) * kstep;
            const char* a3 = a2 + kstep; const char* b3 = b2 + kstep;
            if (last && has_next) S.a_ready(nxt);
            if constexpr (SP2) {
            PG8_LDB(B0, 0, 0); PG8_LDB(B1, 0, 1); PG8_SCHED; PG8_LDA(At, 0, 0); PG8_STAGE(PG8_SA(1, 1), a1 + hstep, voffA);
            PG8_WAIT_V(8); PG8_WAIT_L(0); PG8_BAR; PG8_MMA(0, 0, At, B0); PG8_MMA(0, 1, At, B1); PG8_BAR; PG8_SCHED;
            PG8_LDA(At, 0, 1); PG8_STAGE(PG8_SB(0, 0), b2, voffB); PG8_STAGE(PG8_SB(0, 1), b2 + hstepB, voffB); PG8_STAGE(PG8_SA(0, 0), a2, voffA);
            PG8_WAIT_V(8); PG8_WAIT_L(0); PG8_BAR; PG8_MMA(1, 0, At, B0); PG8_MMA(1, 1, At, B1); PG8_BAR; PG8_SCHED;
            PG8_LDB(B0, 1, 0); PG8_LDB(B1, 1, 1); PG8_SCHED; PG8_LDA(At, 1, 0); PG8_STAGE(PG8_SA(0, 1), a2 + hstep, voffA);
            PG8_WAIT_V(8); PG8_WAIT_L(0); PG8_BAR; PG8_MMA(0, 0, At, B0); PG8_MMA(0, 1, At, B1); PG8_BAR; PG8_SCHED;
            PG8_LDA(At, 1, 1); PG8_STAGE(PG8_SB(1, 0), b3, voffB); PG8_STAGE(PG8_SB(1, 1), b3 + hstepB, voffB); PG8_STAGE(PG8_SA(1, 0), a3, voffA);
            PG8_WAIT_V(8); PG8_WAIT_L(0); PG8_BAR; PG8_MMA(1, 0, At, B0); PG8_MMA(1, 1, At, B1); PG8_BAR; PG8_SCHED;
            } else {
            PG8_LDB(B0, 0, 0); PG8_SCHED; PG8_LDA(At, 0, 0); PG8_STAGE(PG8_SA(1, 1), a1 + hstep, voffA);
            PG8_WAIT_L(8); PG8_BAR; PG8_WAIT_L(0); PG8_MMA(0, 0, At, B0); PG8_BAR; PG8_SCHED;
            PG8_LDB(B1, 0, 1); PG8_STAGE(PG8_SB(0, 0), b2, voffB);
            PG8_BAR; PG8_WAIT_L(0); PG8_MMA(0, 1, At, B1); PG8_BAR;
            PG8_LDA(At, 0, 1); PG8_STAGE(PG8_SA(0, 0), a2, voffA);
            PG8_BAR; PG8_WAIT_L(0); PG8_MMA(1, 0, At, B0); PG8_BAR; PG8_SCHED;
            PG8_STAGE(PG8_SB(0, 1), b2 + hstepB, voffB);
            PG8_WAIT_V(6); PG8_BAR; PG8_MMA(1, 1, At, B1); PG8_BAR;
            PG8_LDB(B0, 1, 0); PG8_SCHED; PG8_LDA(At, 1, 0); PG8_STAGE(PG8_SA(0, 1), a2 + hstep, voffA);
            PG8_WAIT_L(8); PG8_BAR; PG8_WAIT_L(0); PG8_MMA(0, 0, At, B0); PG8_BAR; PG8_SCHED;
            PG8_LDB(B1, 1, 1); PG8_STAGE(PG8_SB(1, 0), b3, voffB);
            PG8_BAR; PG8_WAIT_L(0); PG8_MMA(0, 1, At, B1); PG8_BAR;
            PG8_LDA(At, 1, 1); PG8_STAGE(PG8_SA(1, 0), a3, voffA);
            PG8_BAR; PG8_WAIT_L(0); PG8_MMA(1, 0, At, B0); PG8_BAR; PG8_SCHED;
            PG8_STAGE(PG8_SB(1, 1), b3 + hstepB, voffB);
            PG8_WAIT_V(6); PG8_BAR; PG8_MMA(1, 1, At, B1); PG8_BAR;
            }
        }
        if constexpr (ALIGN_EPI) { if (wr == 0) PG8_BAR; }
        if constexpr (!Epi::AFTER_DRAIN) { E(acc, cur, wr, wc, fr, fq); S.done(cur); }
        if (!has_next) break;
#pragma unroll
        for (int a = 0; a < 2; ++a)
#pragma unroll
            for (int b = 0; b < 2; ++b)
#pragma unroll
                for (int m = 0; m < 4; ++m)
#pragma unroll
                    for (int n = 0; n < 2; ++n) acc[a][b][m][n] = (f32x4){0.f, 0.f, 0.f, 0.f};
        cur = nxt; cA = nA; cB = nB; ++ui;
        if constexpr (ALIGN_EPI) { if (wr == 1) PG8_BAR; }
    }
    PG8_WAIT_V(0);
    if constexpr (!ALIGN_EPI) { if (wr == 0) PG8_BAR; }
    PG8_BAR;
    if constexpr (Epi::AFTER_DRAIN) { E.fused(acc, cur, wr, wc, fr, fq, lds, wid, lane); S.done(cur); }
#undef PG8_SA
#undef PG8_SB
#undef PG8_STAGE
#undef PG8_LDA
#undef PG8_LDB
#undef PG8_MMA
#undef PG8_WAIT_V
#undef PG8_WAIT_L
#undef PG8_BAR
#undef PG8_SCHED
}
}
#define PG8_SP2 true
#define PG8_ALIGN true
#include <hip/hip_bf16.h>
#include <cmath>
namespace attn_body {
using bf16=__hip_bfloat16;
using bf16x8=__attribute__((ext_vector_type(8)))short;
using s16x4=__attribute__((ext_vector_type(4)))short;
using f32x16=__attribute__((ext_vector_type(16)))float;
using u32x4=__attribute__((ext_vector_type(4)))unsigned;
constexpr int BATCH=8,NHEAD=16,SEQ=4096,D=64,DM=NHEAD*D;
constexpr int NW=8,QBLK=32,QB=QBLK*NW,KVBLK=64,NQB=SEQ/QB;
constexpr int ATTN_PITCH=DM, ATTN_UNIT_ROWS=QB;
__device__ __forceinline__ int crow(int r,int hi){return (r&3)+8*(r>>2)+4*hi;}
#define SBAR() __builtin_amdgcn_sched_barrier(0)
__device__ __forceinline__ void cmask(f32x16&p0,f32x16&p1,int jb,int qrel,int hi){
  const float NEG=-INFINITY; int kb=64*jb+4*hi;
  #pragma unroll
  for(int r=0;r<16;++r){int kv=kb+(r&3)+8*(r>>2); if(kv>qrel)p0[r]=NEG; if(kv+32>qrel)p1[r]=NEG;}
}

constexpr int NSLOT=3, SLOTB=8192;
constexpr int LDS_K=0, LDS_V=NSLOT*SLOTB, LDS_WS=2*NSLOT*SLOTB, LDS_OST=LDS_WS+NW*64*4, LDS_KB=LDS_OST+NW*4096, LDS_G=LDS_KB+SEQ*4, LDS_BYTES=LDS_G+NW*4096;
constexpr float C2=0.125f*1.4426950408889634f;
__device__ __forceinline__ void glds16(const void*gsrc,unsigned lds_dst){unsigned keep;
  asm volatile("s_mov_b32 %0, m0\n\ts_mov_b32 m0, %2\n\ts_nop 0\n\tglobal_load_lds_dwordx4 %1, off\n\ts_mov_b32 m0, %0":"=&s"(keep):"v"(gsrc),"s"(lds_dst):"memory");}
__device__ __forceinline__ float max3f(float a,float b,float c){float r;asm("v_max3_f32 %0, %1, %2, %3":"=v"(r):"v"(a),"v"(b),"v"(c));return r;}
__device__ __forceinline__ float max2f(float a,float b){float r;asm("v_max_f32_e32 %0, %1, %2":"=v"(r):"v"(a),"v"(b));return r;}
__device__ __forceinline__ float fadd_s(float a,float b){float r;asm("v_add_f32_e32 %0, %1, %2":"=v"(r):"v"(a),"v"(b));return r;}
__device__ __forceinline__ float fsub_s(float a,float b){float r;asm("v_sub_f32_e32 %0, %1, %2":"=v"(r):"v"(a),"v"(b));return r;}
typedef float f32x2_t __attribute__((ext_vector_type(2))); typedef __bf16 bf16x2_t __attribute__((ext_vector_type(2)));
__device__ __forceinline__ unsigned cvtpk_s(float lo,float hi){f32x2_t v={lo,hi};bf16x2_t b=__builtin_convertvector(v,bf16x2_t);return __builtin_bit_cast(unsigned,b);}
#define WAIT_BAR(N) asm volatile("s_waitcnt vmcnt(" #N ") lgkmcnt(0)\n\ts_barrier":::"memory")

__device__ __forceinline__ void qkt(f32x16&p0,f32x16&p1,const char*Kslot,const bf16x8*qr,const f32x16&negm,int r32,int hi){
  const char*kb=Kslot+hi*1024+r32*16;
  #pragma unroll
  for(int d0=0;d0<4;++d0){
    const bf16x8 b0=*reinterpret_cast<const bf16x8*>(kb+d0*2048);
    const bf16x8 b1=*reinterpret_cast<const bf16x8*>(kb+d0*2048+512);
    if(d0==0){p0=__builtin_amdgcn_mfma_f32_32x32x16_bf16(b0,qr[0],negm,0,0,0);p1=__builtin_amdgcn_mfma_f32_32x32x16_bf16(b1,qr[0],negm,0,0,0);}
    else{p0=__builtin_amdgcn_mfma_f32_32x32x16_bf16(b0,qr[d0],p0,0,0,0);p1=__builtin_amdgcn_mfma_f32_32x32x16_bf16(b1,qr[d0],p1,0,0,0);}}
}
typedef __attribute__((address_space(3))) const char* lds_cptr;
typedef short v4i16_t __attribute__((ext_vector_type(4)));
__device__ __forceinline__ void kload8(bf16x8*kf,lds_cptr kp){
  kf[0]=*(const __attribute__((address_space(3))) bf16x8*)(kp);      kf[1]=*(const __attribute__((address_space(3))) bf16x8*)(kp+512);
  kf[2]=*(const __attribute__((address_space(3))) bf16x8*)(kp+2048); kf[3]=*(const __attribute__((address_space(3))) bf16x8*)(kp+2560);
  kf[4]=*(const __attribute__((address_space(3))) bf16x8*)(kp+4096); kf[5]=*(const __attribute__((address_space(3))) bf16x8*)(kp+4608);
  kf[6]=*(const __attribute__((address_space(3))) bf16x8*)(kp+6144); kf[7]=*(const __attribute__((address_space(3))) bf16x8*)(kp+6656);
}
__device__ __forceinline__ void kload2(bf16x8*kf,lds_cptr kp,int j){ kf[2*j]=*(const __attribute__((address_space(3))) bf16x8*)(kp+j*2048); kf[2*j+1]=*(const __attribute__((address_space(3))) bf16x8*)(kp+j*2048+512); }
__device__ __forceinline__ s16x4 vtr(lds_cptr p){ return __builtin_bit_cast(s16x4,__builtin_amdgcn_ds_read_tr16_b64_v4i16((__attribute__((address_space(3))) v4i16_t*)p)); }
__device__ __forceinline__ float rowmax(const f32x16&p0,const f32x16&p1){
  float a=max3f(p0[0],p0[1],p1[0]),b=max3f(p0[2],p0[3],p1[1]);a=max3f(a,p1[2],p1[3]);
  #pragma unroll
  for(int r=4;r<16;r+=4){a=max3f(a,p0[r],p0[r+1]);b=max3f(b,p0[r+2],p0[r+3]);a=max3f(a,p1[r],p1[r+1]);b=max3f(b,p1[r+2],p1[r+3]);}
  const float m=max2f(a,b);
  auto rr=__builtin_amdgcn_permlane32_swap(__float_as_uint(m),__float_as_uint(m),false,false);
  return max2f(__uint_as_float(rr[0]),__uint_as_float(rr[1]));
}
__device__ __forceinline__ void pv(f32x16*o,int vb,bf16x8 pa0,bf16x8 pa1,bf16x8 pa2,bf16x8 pa3){
  #pragma unroll
  for(int d0=0;d0<2;++d0){s16x4 lo[4],hi[4];
    #pragma unroll
    for(int ks=0;ks<4;++ks){
      asm volatile("ds_read_b64_tr_b16 %0,%1 offset:%c2":"=&v"(lo[ks]):"v"(vb),"i"(d0*4096+ks*1024):"memory");
      asm volatile("ds_read_b64_tr_b16 %0,%1 offset:%c2":"=&v"(hi[ks]):"v"(vb),"i"(d0*4096+ks*1024+512):"memory");}
    asm volatile("s_waitcnt lgkmcnt(0)":::"memory");SBAR();
    #define PK(k) (bf16x8){lo[k][0],lo[k][1],lo[k][2],lo[k][3],hi[k][0],hi[k][1],hi[k][2],hi[k][3]}
    o[d0]=__builtin_amdgcn_mfma_f32_32x32x16_bf16(pa0,PK(0),o[d0],0,0,0);
    o[d0]=__builtin_amdgcn_mfma_f32_32x32x16_bf16(pa1,PK(1),o[d0],0,0,0);
    o[d0]=__builtin_amdgcn_mfma_f32_32x32x16_bf16(pa2,PK(2),o[d0],0,0,0);
    o[d0]=__builtin_amdgcn_mfma_f32_32x32x16_bf16(pa3,PK(3),o[d0],0,0,0);
    #undef PK
  }
}

#ifndef ATTN_STORE16
#define ATTN_STORE16(p,v) (*(u32x4*)(p)=(v))
#endif
typedef float f32x4_t __attribute__((ext_vector_type(4)));
__device__ __forceinline__ float bflo(unsigned v){return __uint_as_float(v<<16);} __device__ __forceinline__ float bfhi(unsigned v){return __uint_as_float(v&0xffff0000u);}
__device__ __forceinline__ unsigned gate2(unsigned ov,unsigned gv){ const float g0=bflo(gv),g1=bfhi(gv); const float s0=__builtin_amdgcn_rcpf(1.f+__builtin_amdgcn_exp2f(-1.4426950408889634f*g0)),s1=__builtin_amdgcn_rcpf(1.f+__builtin_amdgcn_exp2f(-1.4426950408889634f*g1)); return cvtpk_s(bflo(ov)*s0,bfhi(ov)*s1); }
template<int THRL> __device__ __forceinline__ void attn_unit(int b,int h,int qb,const bf16*Q,const bf16*__restrict__ K,const bf16*__restrict__ V,bf16*O,const bf16*__restrict__ Gt,const float*__restrict__ KBg,char*shm){
  int tid_a_=threadIdx.x; asm volatile("":"+v"(tid_a_)); const int tid=tid_a_,lane=tid&63,r32=lane&31,hi=lane>>5; const int wid=__builtin_amdgcn_readfirstlane(tid>>6);
  const long rowbase=(long)b*SEQ; const int q0=qb*QB;
  const bf16*Qw=Q+(rowbase+q0+wid*QBLK)*DM+h*D;
  const bf16*Kh=K+rowbase*DM+h*D,*Vh=V+rowbase*DM+h*D;
  const unsigned lds0=(unsigned)(uintptr_t)shm;
  float*wsf=(float*)(shm+LDS_WS)+wid*64;
  const bf16*ksrc=Kh+(long)lane*DM+wid*8;
  const bf16*vsrc=Vh+(long)(16*(wid&3)+(lane>>2))*DM+(wid>>2)*32+(lane&3)*8;
  const unsigned kdst=lds0+LDS_K+wid*1024, vdst=lds0+LDS_V+wid*1024;
  #define DMA_K(t,slot) glds16(ksrc+(long)(t)*KVBLK*DM,(unsigned)__builtin_amdgcn_readfirstlane(kdst+(slot)))
  #define DMA_V(t,slot) glds16(vsrc+(long)(t)*KVBLK*DM,(unsigned)__builtin_amdgcn_readfirstlane(vdst+(slot)))
  const int vb0=(int)(lds0+LDS_V)+((lane>>4)&1)*32+(lane&3)*8+(4*hi+((lane&15)>>2))*64;
  const char*Kbase=shm+LDS_K; bf16x8 kf[8];
  const lds_cptr shm3=(lds_cptr)shm; const lds_cptr kp0=shm3+LDS_K+hi*1024+r32*16; const lds_cptr vp0=shm3+LDS_V+((lane>>4)&1)*32+(lane&3)*8+(4*hi+((lane&15)>>2))*64;
  { const float*kbrow_=KBg+((long)b*NHEAD+h)*SEQ;
    _Pragma("unroll") for(int j_=0;j_<2;++j_){ const int p_=wid+8*j_; if(p_*256<q0+QB) glds16(kbrow_+p_*256+lane*4,(unsigned)__builtin_amdgcn_readfirstlane(lds0+LDS_KB+p_*1024)); }
    const bf16*Gw_=Gt+(rowbase+q0+wid*QBLK)*DM+h*D;
    _Pragma("unroll") for(int i_=0;i_<4;++i_) glds16(Gw_+(long)(i_*8+(lane>>3))*DM+(lane&7)*8,(unsigned)__builtin_amdgcn_readfirstlane(lds0+LDS_G+wid*4096+i_*1024)); }
  #define KBIAS(P0,P1,t) do{ const __attribute__((address_space(3))) f32x4_t*kp_=(const __attribute__((address_space(3))) f32x4_t*)(shm3+LDS_KB+(t)*256+hi*16); \
    _Pragma("unroll") for(int g_=0;g_<4;++g_){ const f32x4_t b0_=kp_[2*g_],b1_=kp_[8+2*g_]; \
      P0[4*g_]+=b0_[0];P0[4*g_+1]+=b0_[1];P0[4*g_+2]+=b0_[2];P0[4*g_+3]+=b0_[3]; P1[4*g_]+=b1_[0];P1[4*g_+1]+=b1_[1];P1[4*g_+2]+=b1_[2];P1[4*g_+3]+=b1_[3]; } }while(0)
  const int NT=(q0+QB)/KVBLK;
  DMA_K(0,0);DMA_V(0,0);DMA_K(1,SLOTB);
  bf16x8 qr[4];
  #pragma unroll
  for(int d0=0;d0<4;++d0)qr[d0]=*reinterpret_cast<const bf16x8*>(&Qw[(long)r32*DM+d0*16+hi*8]);
  float mhat=0.f,l_reg=0.f;f32x16 o[2];o[0]=f32x16{};o[1]=f32x16{};f32x16 negm=f32x16{};asm volatile("":"+v"(negm));
  const int qrel=wid*QBLK+r32;
  #define CMASK(P0,P1,t) do{int jb_=(t)-(NT-4); if(jb_>=0)cmask(P0,P1,jb_,qrel,hi);}while(0)
  bool resc=false;
  #define START(P0,P1) do{ const float rm=rowmax(P0,P1); resc=false; \
    { const float dl=rm; mhat=fadd_s(mhat,dl); \
      _Pragma("unroll") for(int r=0;r<16;++r){P0[r]=fsub_s(P0[r],dl);P1[r]=fsub_s(P1[r],dl);} \
      _Pragma("unroll") for(int r=0;r<16;++r)negm[r]=-mhat; asm volatile("":"+v"(negm)); } \
    _Pragma("unroll") for(int r=0;r<16;++r)P0[r]=__builtin_amdgcn_exp2f(P0[r]); }while(0)
  #define RESC() do{ if(resc){ asm volatile("s_waitcnt lgkmcnt(0)":::"memory"); \
      _Pragma("unroll") for(int d_=0;d_<2;++d_) _Pragma("unroll") for(int r=0;r<16;++r)o[d_][r]*=wsf[crow(r,hi)]; } }while(0)
  f32x16 pA0,pA1,pB0,pB1;
  int sl_prev=0,sl_cur=0,sl_next=SLOTB;
  #define ROT() do{sl_prev=sl_cur;sl_cur=sl_next;sl_next=(sl_next==(NSLOT-1)*SLOTB)?0:sl_next+SLOTB;}while(0)
  DMA_K(2,2*SLOTB);
  WAIT_BAR(3);
  qkt(pA0,pA1,Kbase,qr,negm,r32,hi);asm volatile("s_nop 15\n\ts_nop 7":"+v"(pA0),"+v"(pA1));KBIAS(pA0,pA1,0);CMASK(pA0,pA1,0);
  START(pA0,pA1);
  _Pragma("unroll") for(int r=0;r<16;++r)pA1[r]=__builtin_amdgcn_exp2f(pA1[r]);
  WAIT_BAR(0);
  DMA_K(3,0);DMA_V(1,SLOTB);
  ROT();
  kload8(kf,kp0+sl_cur);
  WAIT_BAR(2);
  s16x4 vlo[8],vhi[8]; u32x4 pw0,pw1,pw2,pw3;
  #define PKW(P,B) cvtpk_s(P[B],P[B+1])
  #define PAF(k) __builtin_bit_cast(bf16x8,pw##k)
  #define VFR(i) (bf16x8){vlo[i][0],vlo[i][1],vlo[i][2],vlo[i][3],vhi[i][0],vhi[i][1],vhi[i][2],vhi[i][3]}
  #define PIN(x) asm volatile("":"+v"(x))
  #define MX3(a,b,c) __builtin_fmaxf(__builtin_fmaxf((a),(b)),(c))
  #define GAPA(MF,A0,A1,A2,A3,W0,W1,PW) do{ MF; sacc+=A0; sacc+=A1; sacc+=A2; sacc+=A3; PIN(sacc); W0; W1; PIN(PW); SBAR(); }while(0)
  #define EX(v) __builtin_amdgcn_exp2f(v)
  #define GAPB(MF,X,B) do{ MF; X[B]=EX(X[B]); X[B+1]=EX(X[B+1]); X[B+2]=EX(X[B+2]); X[B+3]=EX(X[B+3]); PIN(X); SBAR(); }while(0)
  #define VRD(i) do{ vlo[i]=vtr(vp_+(((i)>>2)*4096+((i)&3)*1024)); vhi[i]=vtr(vp_+(((i)>>2)*4096+((i)&3)*1024+512)); }while(0)
  #define KRD(G,j) do{ if(G){ kload2(kf,kp0+sl_next,j); SBAR(); } }while(0)
  #define STEP(C0,C1,P0,P1,t,GK,GV,GL) do{ SBAR(); \
    const lds_cptr vp_=vp0+sl_prev; \
    VRD(0); SBAR(); float sacc=(P0[0]+P0[1]); \
    GAPA(C0=__builtin_amdgcn_mfma_f32_32x32x16_bf16(kf[0],qr[0],negm,0,0,0), P0[2],P0[3],P0[4],P0[5],     pw0[0]=PKW(P0,0), pw0[1]=PKW(P0,2), pw0); \
    VRD(4); SBAR(); GAPA(C1=__builtin_amdgcn_mfma_f32_32x32x16_bf16(kf[1],qr[0],negm,0,0,0), P0[6],P0[7],P0[8],P0[9],     pw0[2]=PKW(P0,4), pw0[3]=PKW(P0,6), pw0); \
    VRD(1); SBAR(); GAPA(C0=__builtin_amdgcn_mfma_f32_32x32x16_bf16(kf[2],qr[1],C0,0,0,0),   P0[10],P0[11],P0[12],P0[13], pw1[0]=PKW(P0,8), pw1[1]=PKW(P0,10), pw1); \
    VRD(5); SBAR(); GAPA(C1=__builtin_amdgcn_mfma_f32_32x32x16_bf16(kf[3],qr[1],C1,0,0,0),   P0[14],P0[15],P1[0],P1[1],   pw1[2]=PKW(P0,12),pw1[3]=PKW(P0,14), pw1); \
    VRD(2); SBAR(); GAPA(C0=__builtin_amdgcn_mfma_f32_32x32x16_bf16(kf[4],qr[2],C0,0,0,0),   P1[2],P1[3],P1[4],P1[5],     pw2[0]=PKW(P1,0), pw2[1]=PKW(P1,2), pw2); \
    VRD(6); SBAR(); GAPA(C1=__builtin_amdgcn_mfma_f32_32x32x16_bf16(kf[5],qr[2],C1,0,0,0),   P1[6],P1[7],P1[8],P1[9],     pw2[2]=PKW(P1,4), pw2[3]=PKW(P1,6), pw2); \
    VRD(3); SBAR(); GAPA(C0=__builtin_amdgcn_mfma_f32_32x32x16_bf16(kf[6],qr[3],C0,0,0,0),   P1[10],P1[11],P1[12],P1[13], pw3[0]=PKW(P1,8), pw3[1]=PKW(P1,10), pw3); \
    VRD(7); SBAR(); GAPA(C1=__builtin_amdgcn_mfma_f32_32x32x16_bf16(kf[7],qr[3],C1,0,0,0),   P1[14],P1[15],0.f,0.f,       pw3[2]=PKW(P1,12),pw3[3]=PKW(P1,14), pw3); \
    l_reg+=sacc; \
    if(GK){DMA_K((t)+3,sl_cur);} if(GV){DMA_V((t)+1,sl_next);} \
    KBIAS(C0,C1,t); CMASK(C0,C1,t); \
    { float a=MX3(C0[0],C0[1],C1[0]),b=MX3(C0[2],C0[3],C1[1]); a=MX3(a,C1[2],C1[3]); \
      _Pragma("unroll") for(int r=4;r<16;r+=4){a=MX3(a,C0[r],C0[r+1]);b=MX3(b,C0[r+2],C0[r+3]);a=MX3(a,C1[r],C1[r+1]);b=MX3(b,C1[r+2],C1[r+3]);} \
      float rm=__builtin_fmaxf(a,b); { auto rr=__builtin_amdgcn_permlane32_swap(__float_as_uint(rm),__float_as_uint(rm),false,false); rm=__builtin_fmaxf(__uint_as_float(rr[0]),__uint_as_float(rr[1])); } \
      resc=false; \
      if(__builtin_expect(__any(rm>(float)THRL),0)){ const float dl=__builtin_fmaxf(rm,0.f); mhat+=dl; \
        _Pragma("unroll") for(int r=0;r<16;++r){C0[r]-=dl;C1[r]-=dl;} \
        _Pragma("unroll") for(int r=0;r<16;++r)negm[r]=-mhat; asm volatile("":"+v"(negm)); \
        const float f=__builtin_amdgcn_exp2f(-dl); l_reg*=f; if(hi==0)wsf[r32]=f; resc=true; } } \
    SBAR(); \
    GAPB(o[0]=__builtin_amdgcn_mfma_f32_32x32x16_bf16(PAF(0),VFR(0),o[0],0,0,0), C0,0); \
    GAPB(o[1]=__builtin_amdgcn_mfma_f32_32x32x16_bf16(PAF(0),VFR(4),o[1],0,0,0), C0,4); \
    KRD(GL,0); GAPB(o[0]=__builtin_amdgcn_mfma_f32_32x32x16_bf16(PAF(1),VFR(1),o[0],0,0,0), C0,8); \
    KRD(GL,1); GAPB(o[1]=__builtin_amdgcn_mfma_f32_32x32x16_bf16(PAF(1),VFR(5),o[1],0,0,0), C0,12); \
    KRD(GL,2); GAPB(o[0]=__builtin_amdgcn_mfma_f32_32x32x16_bf16(PAF(2),VFR(2),o[0],0,0,0), C1,0); \
    KRD(GL,3); GAPB(o[1]=__builtin_amdgcn_mfma_f32_32x32x16_bf16(PAF(2),VFR(6),o[1],0,0,0), C1,4); \
    GAPB(o[0]=__builtin_amdgcn_mfma_f32_32x32x16_bf16(PAF(3),VFR(3),o[0],0,0,0), C1,8); \
    GAPB(o[1]=__builtin_amdgcn_mfma_f32_32x32x16_bf16(PAF(3),VFR(7),o[1],0,0,0), C1,12); \
    }while(0)
  int t=1;
  #undef CMASK
  #define CMASK(P0,P1,t) do{}while(0)
  for(;t+5<NT;t+=2){
    STEP(pB0,pB1,pA0,pA1,t,true,true,true);     WAIT_BAR(2); RESC(); ROT();
    STEP(pA0,pA1,pB0,pB1,t+1,true,true,true);   WAIT_BAR(2); RESC(); ROT();
  }
  #undef CMASK
  #define CMASK(P0,P1,t) do{int jb_=(t)-(NT-4); if(jb_>=0)cmask(P0,P1,jb_,qrel,hi);}while(0)
  #define ENDW(tt) do{ if((tt)+3<NT){WAIT_BAR(2);} else if((tt)+2<NT){WAIT_BAR(1);} else {WAIT_BAR(0);} }while(0)
  for(;t+1<NT;t+=2){
    STEP(pB0,pB1,pA0,pA1,t,(t+3<NT),(t+1<NT),(t+1<NT));       ENDW(t);   RESC(); ROT();
    STEP(pA0,pA1,pB0,pB1,t+1,(t+4<NT),(t+2<NT),(t+2<NT));     ENDW(t+1); RESC(); ROT();
  }
  STEP(pB0,pB1,pA0,pA1,NT-1,false,false,false); RESC();
  { float sacc=pB0[0]+pB0[1]; _Pragma("unroll") for(int r=2;r<16;++r)sacc+=pB0[r]; _Pragma("unroll") for(int r=0;r<16;++r)sacc+=pB1[r]; l_reg+=sacc;
    pw0=(u32x4){PKW(pB0,0),PKW(pB0,2),PKW(pB0,4),PKW(pB0,6)};pw1=(u32x4){PKW(pB0,8),PKW(pB0,10),PKW(pB0,12),PKW(pB0,14)};pw2=(u32x4){PKW(pB1,0),PKW(pB1,2),PKW(pB1,4),PKW(pB1,6)};pw3=(u32x4){PKW(pB1,8),PKW(pB1,10),PKW(pB1,12),PKW(pB1,14)};
    SBAR(); pv(o,vb0+sl_cur,PAF(0),PAF(1),PAF(2),PAF(3)); }
  #undef PKW
  #undef PAF
  #undef VFR
  #undef PIN
  #undef MX3
  #undef GAPA
  #undef GAPB
  #undef EX
  #undef VRD
  #undef KRD
  #undef STEP
  #undef ENDW
  {auto rr=__builtin_amdgcn_permlane32_swap(__float_as_uint(l_reg),__float_as_uint(l_reg),false,false);l_reg=__uint_as_float(rr[0])+__uint_as_float(rr[1]);}
  if(hi==0)wsf[32+r32]=l_reg;asm volatile("s_waitcnt lgkmcnt(0)":::"memory");
  float rli[16];
  #pragma unroll
  for(int r=0;r<16;++r)rli[r]=__builtin_amdgcn_rcpf(wsf[32+crow(r,hi)]);
  bf16*Ow=O+(rowbase+q0+wid*QBLK)*DM+h*D; const bf16*gstg=(const bf16*)(shm+LDS_G)+wid*2048;
  { bf16*stg=(bf16*)(shm+LDS_OST)+wid*2048;
    #pragma unroll
    for(int r=0;r<16;++r){const int orow=crow(r,hi);
      #pragma unroll
      for(int d0=0;d0<2;++d0)stg[orow*64+d0*32+r32]=__float2bfloat16(o[d0][r]*rli[r]);}
    asm volatile("s_waitcnt lgkmcnt(0)":::"memory");
    #pragma unroll
    for(int i=0;i<4;++i){const int row=i*8+(lane>>3),ch=lane&7; u32x4 v=*(const u32x4*)(stg+row*64+ch*8); const u32x4 gv=*(const u32x4*)(gstg+row*64+ch*8); v.x=gate2(v.x,gv.x);v.y=gate2(v.y,gv.y);v.z=gate2(v.z,gv.z);v.w=gate2(v.w,gv.w); ATTN_STORE16(Ow+(long)row*DM+ch*8,v);} }
  asm volatile("s_waitcnt lgkmcnt(0)\n\ts_barrier":::"memory");
  #undef KBIAS
  #undef DMA_K
  #undef DMA_V
  #undef CMASK
  #undef START
  #undef RESC
  #undef ROT
}
constexpr int ATTN_LDS_BYTES=LDS_BYTES;
struct AttnTensors { const bf16* Q; const bf16* K; const bf16* V; bf16* O; const bf16* G; const float* KB; unsigned long long* ts; };
struct AttnUnit { int bh; int qb; };
struct StaticOrder {
  int vcu;
  int G_;
  __device__ __forceinline__ explicit StaticOrder(int grid,int block):vcu((grid%8==0)?(block%8)*(grid/8)+block/8:block),G_(grid){}
  __device__ __forceinline__ bool next(int i,AttnUnit&u)const{ const int pu=vcu+(i>>1)*G_; if(pu>=BATCH*NHEAD*(NQB/2))return false; const int s=pu%(NQB/2); int bh=pu/(NQB/2); if(G_==256)bh=(bh&~15)|((bh+4*(i>>1))&15); u.bh=bh; u.qb=(i&1)?(NQB-1-s):s; return true; }
  __device__ __forceinline__ void a_ready(const AttnUnit&)const{}
  __device__ __forceinline__ void done(const AttnUnit&)const{}
};
template<class Sched,int THRL=8> __device__ __forceinline__ void attn_phase(char*lds,const AttnTensors&T,const Sched&S){
  AttnUnit u;
  for(int i=0;S.next(i,u);++i){ if(T.ts&&blockIdx.x==0&&threadIdx.x==0)T.ts[32+i]=__builtin_amdgcn_s_memrealtime(); S.a_ready(u); attn_unit<THRL>(u.bh/NHEAD,u.bh%NHEAD,u.qb,T.Q,T.K,T.V,T.O,T.G,T.KB,lds); S.done(u); }
}
#undef SBAR
#undef WAIT_BAR
}
#define GAS __attribute__((address_space(1)))
#define LAS __attribute__((address_space(3)))
typedef unsigned short bf16;
typedef unsigned v4u __attribute__((ext_vector_type(4)));
typedef float f32x4 __attribute__((ext_vector_type(4)));
typedef short bf16x8 __attribute__((ext_vector_type(8)));
typedef GAS unsigned gu32;
typedef GAS unsigned long long gu64;
#define RLX_AGENT __ATOMIC_RELAXED, __HIP_MEMORY_SCOPE_AGENT
#define LDS_WAIT() asm volatile("s_waitcnt lgkmcnt(0)" ::: "memory")
#define VM_WAIT() asm volatile("s_waitcnt vmcnt(0)" ::: "memory")
__device__ __forceinline__ unsigned long long rt() { return __builtin_amdgcn_s_memrealtime(); }
__device__ __forceinline__ unsigned f2bf(float f) { unsigned u = __builtin_bit_cast(unsigned, f); return (u + 0x7fffu + ((u >> 16) & 1u)) >> 16; }
__device__ __forceinline__ unsigned pk2(float lo, float hi) { return f2bf(lo) | (f2bf(hi) << 16); }

#define XB_TMO      128
#define XB_XCNT(j)  (256  + 64 * (j))
#define XB_XSUB(j)  (1280 + 64 * (j))
#define XB_XGEN(j)  (2304 + 64 * (j))
#define XB_TOP      3328
#define XB_TOPGEN   3392
#define XCD_BAR_WORDS 3456
#define XB_SPIN_CAP (1u << 18)

__device__ __forceinline__ unsigned xb_ld(unsigned* p)              { return __hip_atomic_load(p, __ATOMIC_RELAXED, __HIP_MEMORY_SCOPE_AGENT); }
__device__ __forceinline__ unsigned xb_add(unsigned* p, unsigned v) { return __hip_atomic_fetch_add(p, v, __ATOMIC_RELAXED, __HIP_MEMORY_SCOPE_AGENT); }
__device__ __forceinline__ unsigned xb_xcc_id() { return (unsigned)__builtin_amdgcn_s_getreg((3 << 11) | 20) & 0xFu; }
#define XB_SPIN(cond, bar) do { unsigned _sp = 0; while (cond) { __builtin_amdgcn_s_sleep(1); \
    if ((++_sp & 255u) == 0u) { if (xb_ld(&(bar)[XB_TMO])) break; if (_sp > XB_SPIN_CAP) { atomicAdd(&(bar)[XB_TMO], 1u); break; } } } } while (0)

struct XcdBarrier {
    unsigned* bar; unsigned x;
    volatile LAS unsigned* st;
};

__device__ __forceinline__ XcdBarrier xcd_barrier_post(unsigned* bar, volatile LAS unsigned* st) {
    XcdBarrier b; b.bar = bar; b.x = xb_xcc_id(); b.st = st;
    if (threadIdx.x == 0) (void)xb_add(&bar[XB_XCNT(b.x)], 1u);
    return b;
}
__device__ __forceinline__ void xcd_barrier_complete(unsigned* bar, unsigned x, unsigned& nloc, unsigned& nx) {
    const unsigned G = gridDim.x * gridDim.y * gridDim.z;
    unsigned sum, cnt, mine, sp = 0u;
    for (;;) {
        sum = 0u; cnt = 0u; mine = 0u;
#pragma unroll
        for (unsigned j = 0; j < 16; ++j) { const unsigned c = xb_ld(&bar[XB_XCNT(j)]); sum += c; cnt += (c > 0u) ? 1u : 0u; mine = (j == x) ? c : mine; }
        if (sum == G) break;
        __builtin_amdgcn_s_sleep(1);
        if ((++sp & 255u) == 0u) { if (xb_ld(&bar[XB_TMO])) break; if (sp > XB_SPIN_CAP) { atomicAdd(&bar[XB_TMO], 1u); break; } }
    }
    nloc = mine > 0u ? mine : 1u; nx = cnt > 0u ? cnt : 1u;
}

__device__ __forceinline__ void xcd_barrier(const XcdBarrier& b) {
    asm volatile("s_waitcnt vmcnt(0)" ::: "memory");
    __syncthreads();
    if (threadIdx.x == 0) {
        unsigned* bar = b.bar;
        __builtin_amdgcn_s_waitcnt(0);
        unsigned nloc = b.st[0], nx = b.st[1];
        if (nloc == 0u) { xcd_barrier_complete(bar, b.x, nloc, nx); b.st[0] = nloc; b.st[1] = nx; }
        const unsigned old = xb_add(&bar[XB_XSUB(b.x)], 1u);
        const unsigned gen = old / nloc;
        if (old + 1u == (gen + 1u) * nloc) {
            __builtin_amdgcn_fence(__ATOMIC_RELEASE, "agent");
            asm volatile("s_waitcnt vmcnt(0)" ::: "memory");
            const unsigned og = xb_add(&bar[XB_TOP], 1u);
            const unsigned tg = og / nx;
            if (og + 1u == (tg + 1u) * nx) xb_add(&bar[XB_TOPGEN], 1u);
            else XB_SPIN(xb_ld(&bar[XB_TOPGEN]) == tg, bar);
            __builtin_amdgcn_fence(__ATOMIC_ACQUIRE, "agent");
            xb_add(&bar[XB_XGEN(b.x)], 1u);
            asm volatile("s_waitcnt vmcnt(0)" ::: "memory");
        } else {
            XB_SPIN(xb_ld(&bar[XB_XGEN(b.x)]) == gen, bar);
            __builtin_amdgcn_fence(__ATOMIC_ACQUIRE, "agent");
            asm volatile("s_waitcnt vmcnt(0)" ::: "memory");
        }
    }
    __syncthreads();
}
namespace cg = cooperative_groups;
constexpr int NWAVES = 8;
constexpr int BATCH = 8, SEQ = 4096, D = 1024, FF = 4096, M = BATCH * SEQ;
constexpr int N0 = 2816;
constexpr int N1 = 4352;
constexpr int EVEN_IN = 2576, ODD_IN = 4112;
constexpr float LN_EPS = 1e-5f;
constexpr size_t MiB = 1u << 20;
constexpr size_t WS_CTL = 0, CTL_ZERO_BYTES = 1 * MiB;
constexpr size_t WS_MOD = 1 * MiB, WS_BIAS0 = 1 * MiB + 512 * 1024;
constexpr size_t WS_WIN0 = 2 * MiB, WS_WOUT0 = 8 * MiB, WS_W1_0 = 10 * MiB, WS_W2_0 = 18 * MiB, WS_WIN1 = 26 * MiB, WS_WOUT1 = 35 * MiB, WS_W1_1 = 37 * MiB, WS_W2_1 = 45 * MiB;
constexpr size_t WS_RGP = 54 * MiB, WS_RGH = 56 * MiB, WS_RGC = 58 * MiB, WS_GDEC = 60 * MiB, WS_RGWT = 60 * MiB + 512 * 1024, WS_FL = 61 * MiB, WS_KB = 63 * MiB;
constexpr size_t WS_U = 66 * MiB, WS_MIX = 130 * MiB, WS_PROJ = 194 * MiB, WS_GKV = 370 * MiB, WS_END = 450 * MiB;
constexpr size_t QKVG_STRIDE = 64 * MiB / 2;
constexpr int CW_BAR = 4096;
constexpr int RING_BYTES = 143360, LDSCTL_OFF = RING_BYTES, MISC_OFF = LDSCTL_OFF + 320, LDS_BYTES = 147456;
static_assert(attn_body::ATTN_LDS_BYTES <= RING_BYTES, "attention LDS");

struct Frame {
    LAS unsigned char* lds; volatile LAS unsigned* MISC; gu32* ctl;
    int vcu, G;
    unsigned char* ws;
};
__device__ __forceinline__ const float* inp(int i) { const __attribute__((address_space(4))) unsigned long long* k = (const __attribute__((address_space(4))) unsigned long long*)__builtin_amdgcn_kernarg_segment_ptr(); asm volatile("" : "+s"(k)); return (const float*)(const __attribute__((address_space(1))) float*)k[i]; }
#define WSP(T, off) ((T*)(F.ws + (off)))
#define PHASE_IDS int tid_ = threadIdx.x; asm volatile("" : "+v"(tid_)); const int tid = tid_, lane = tid & 63, wave = __builtin_amdgcn_readfirstlane(tid >> 6); (void)lane; (void)wave;
__device__ __forceinline__ float bf2f(bf16 v) { return __uint_as_float((unsigned)v << 16); }
__device__ __forceinline__ float sigmoid_f(float x) { return 1.f / (1.f + __expf(-x)); }
__device__ __forceinline__ float logsigmoid_f(float x) { return fminf(x, 0.f) - log1pf(expf(-fabsf(x))); }
__device__ __forceinline__ float gelu_tanh_f(float x) { return 0.5f * x * (1.f + tanhf(0.7978845608028654f * (x + 0.044715f * x * x * x))); }
__device__ __forceinline__ float wave_sum(float v) {
#pragma unroll
    for (int o = 1; o < 64; o <<= 1) v += __shfl_xor(v, o);
    return v;
}
__device__ __forceinline__ void p0_write_tile(bf16* WT, int K, int row0, int k0, LAS float* scr, int lane) {
    const int c = lane & 7;
#pragma unroll
    for (int j = 0; j < 4; ++j) { const int n = (lane >> 3) + 8 * j; const LAS float* s = scr + (8 * c) * 33 + n;
        v4u o; o.x = pk2(s[0 * 33], s[1 * 33]); o.y = pk2(s[2 * 33], s[3 * 33]); o.z = pk2(s[4 * 33], s[5 * 33]); o.w = pk2(s[6 * 33], s[7 * 33]);
        *(GAS v4u*)(WT + (size_t)(row0 + n) * K + k0 + 8 * c) = o; }
    LDS_WAIT(); asm volatile("" ::: "memory");
}
__device__ __forceinline__ void p0_transpose_item(const float* W, int ldw, int ncols, int K, int nblk, bf16* WT, int row_off, LAS float* scr, int item, int lane) {
    const int kb = item / nblk, nb = item % nblk, k0 = 64 * kb, n0 = 32 * nb; const int n = n0 + (lane & 31);
#pragma unroll 8
    for (int i = 0; i < 32; ++i) { const int kk = 2 * i + (lane >> 5); scr[kk * 33 + (lane & 31)] = (n < ncols) ? W[(size_t)(k0 + kk) * ldw + n] : 0.f; }
    LDS_WAIT(); asm volatile("" ::: "memory");
    p0_write_tile(WT, K, row_off + n0, k0, scr, lane);
}
__device__ __forceinline__ void p0_zup_item(const float* Win, const float* wup, bf16* WT, LAS float* scr, int item, int lane) {
    const int kb = item >> 3, jb = item & 7, k = 64 * kb + lane;
    f32x4 z[4];
#pragma unroll
    for (int q = 0; q < 4; ++q) z[q] = *(const f32x4*)(Win + (size_t)k * EVEN_IN + 2560 + 4 * q);
#pragma unroll 4
    for (int jj = 0; jj < 32; ++jj) { float acc = 0.f;
#pragma unroll
        for (int r = 0; r < 16; ++r) acc += z[r >> 2][r & 3] * wup[r * 256 + 32 * jb + jj];
        scr[lane * 33 + jj] = acc; }
    LDS_WAIT(); asm volatile("" ::: "memory");
    p0_write_tile(WT, D, 2560 + 32 * jb, 64 * kb, scr, lane);
}
__device__ __forceinline__ void p0a_phase(Frame& F) {
    PHASE_IDS
    if (F.vcu < 192) {
        LAS float* sc = (LAS float*)F.lds; LAS float* red = (LAS float*)(F.lds + 32768);
        for (int i = tid; i < BATCH * D; i += NWAVES * 64) { const float cv = inp(1)[i]; sc[i] = cv / (1.f + expf(-cv)); }
        __syncthreads();
        for (int item = F.vcu; item < 192; item += F.G) {
            const int ls = item / 48, cb = item % 48, col = cb * 64 + lane; const float* w = inp(2) + (size_t)ls * D * 3072 + col;
            float acc[8];
#pragma unroll
            for (int b = 0; b < 8; ++b) acc[b] = 0.f;
#pragma unroll 4
            for (int kk = 0; kk < 128; ++kk) { const int k = wave * 128 + kk; const float wv = w[(size_t)k * 3072];
#pragma unroll
                for (int b = 0; b < 8; ++b) acc[b] += sc[b * D + k] * wv; }
#pragma unroll
            for (int b = 0; b < 8; ++b) red[(wave * 8 + b) * 64 + lane] = acc[b];
            __syncthreads();
            { const int b = tid >> 6, l = tid & 63; float s = inp(3)[ls * 3072 + cb * 64 + l];
#pragma unroll
              for (int w8 = 0; w8 < 8; ++w8) s += red[(w8 * 8 + b) * 64 + l];
              WSP(float, WS_MOD)[(size_t)(ls * 8 + b) * 3072 + cb * 64 + l] = s; }
            __syncthreads();
        }
    }
    __syncthreads();
    LAS float* scr = (LAS float*)(F.lds + 49152 + wave * 8448);
    const int gw = F.vcu * NWAVES + wave, NGW = F.G * NWAVES;
    constexpr int I_IN0 = 16 * 80, I_ZUP = 128, I_OUT = 16 * 32, I_W1 = 16 * 128, I_W2 = 64 * 32, I_IN1 = 16 * 129;
    constexpr int NITEMS = I_IN0 + I_ZUP + 2 * I_OUT + 2 * I_W1 + 2 * I_W2 + I_IN1;
    for (int it = gw; it < NITEMS; it += NGW) {
        int r = it;
        if (r < I_IN0) { p0_transpose_item(inp(6), EVEN_IN, 2560, D, 80, WSP(bf16, WS_WIN0), 0, scr, r, lane); continue; } r -= I_IN0;
        if (r < I_ZUP) { p0_zup_item(inp(6), inp(14), WSP(bf16, WS_WIN0), scr, r, lane); continue; } r -= I_ZUP;
        if (r < I_OUT) { p0_transpose_item(inp(17), D, D, D, 32, WSP(bf16, WS_WOUT0), 0, scr, r, lane); continue; } r -= I_OUT;
        if (r < I_OUT) { p0_transpose_item(inp(22), D, D, D, 32, WSP(bf16, WS_WOUT1), 0, scr, r, lane); continue; } r -= I_OUT;
        if (r < I_W1) { p0_transpose_item(inp(23), FF, FF, D, 128, WSP(bf16, WS_W1_0), 0, scr, r, lane); continue; } r -= I_W1;
        if (r < I_W1) { p0_transpose_item(inp(23) + (size_t)D * FF, FF, FF, D, 128, WSP(bf16, WS_W1_1), 0, scr, r, lane); continue; } r -= I_W1;
        if (r < I_W2) { p0_transpose_item(inp(25), D, D, FF, 32, WSP(bf16, WS_W2_0), 0, scr, r, lane); continue; } r -= I_W2;
        if (r < I_W2) { p0_transpose_item(inp(25) + (size_t)FF * D, D, D, FF, 32, WSP(bf16, WS_W2_1), 0, scr, r, lane); continue; } r -= I_W2;
        p0_transpose_item(inp(18), ODD_IN, ODD_IN, D, 129, WSP(bf16, WS_WIN1), 0, scr, r, lane);
    }
    { const int gt = F.vcu * NWAVES * 64 + tid, NGT = F.G * NWAVES * 64; v4u* z = (v4u*)(WSP(bf16, WS_WIN1) + (size_t)4128 * D);
      for (int i = gt; i < (N1 - 4128) * D * 2 / 16; i += NGT) z[i] = (v4u){0u, 0u, 0u, 0u};
      for (int i = gt; i < N0; i += NGT) WSP(float, WS_BIAS0)[i] = (i < 2560) ? 0.f : inp(15)[i - 2560];
      for (int i = gt; i < 2 * 8 * 64 * 64; i += NGT) { const int k = i & 63, j = (i >> 6) & 63, n = (i >> 12) & 7, g = i >> 15; WSP(bf16, WS_RGWT)[i] = (bf16)f2bf((g ? inp(11) : inp(9))[(n * 64 + k) * 64 + j]); } }
}
__device__ __forceinline__ void modulate_phase(Frame& F, const float* x, const float* mod  , bf16* U) {
    PHASE_IDS
    const int gw = F.vcu * NWAVES + wave, NGW = F.G * NWAVES;
    for (int m = gw; m < M; m += NGW) {
        const GAS f32x4* xr = (const GAS f32x4*)(x + (size_t)m * D) + lane; const float* md = mod + (size_t)(m / SEQ) * 3072;
        GAS unsigned long long* o8 = (GAS unsigned long long*)(U + (size_t)m * D) + lane;
#pragma unroll
        for (int j = 0; j < 4; ++j) { const f32x4 v = xr[64 * j]; const f32x4 sh = *(const f32x4*)(md + 4 * lane + 256 * j), scl = *(const f32x4*)(md + D + 4 * lane + 256 * j);
            const f32x4 u = v * (scl + 1.0f) + sh; o8[64 * j] = (unsigned long long)pk2(u.x, u.y) | ((unsigned long long)pk2(u.z, u.w) << 32); }
    }
}
template <bool HAS_NEXT> __device__ __forceinline__ void ln_phase(Frame& F, float* xbuf, const float* g, const float* bb, const float* modn, bf16* U) {
    PHASE_IDS
    const int gw = F.vcu * NWAVES + wave, NGW = F.G * NWAVES;
    for (int m = gw; m < M; m += NGW) {
        GAS f32x4* xr = (GAS f32x4*)(xbuf + (size_t)m * D) + lane;
        f32x4 v[4]; float s = 0.f;
#pragma unroll
        for (int j = 0; j < 4; ++j) { v[j] = xr[64 * j]; s += (v[j].x + v[j].y) + (v[j].z + v[j].w); }
        const float mean = wave_sum(s) * (1.f / D); float s2 = 0.f;
#pragma unroll
        for (int j = 0; j < 4; ++j) { v[j] = v[j] - mean; s2 += (v[j].x * v[j].x + v[j].y * v[j].y) + (v[j].z * v[j].z + v[j].w * v[j].w); }
        const float rstd = 1.f / sqrtf(wave_sum(s2) * (1.f / D) + LN_EPS);
        const float* md = HAS_NEXT ? modn + (size_t)(m / SEQ) * 3072 : nullptr;
        GAS unsigned long long* o8 = (GAS unsigned long long*)(U + (size_t)m * D) + lane;
#pragma unroll
        for (int j = 0; j < 4; ++j) { const int col = 4 * lane + 256 * j; const f32x4 y = v[j] * rstd * *(const f32x4*)(g + col) + *(const f32x4*)(bb + col);
            xr[64 * j] = y;
            if (HAS_NEXT) { const f32x4 u = y * (*(const f32x4*)(md + D + col) + 1.0f) + *(const f32x4*)(md + col); o8[64 * j] = (unsigned long long)pk2(u.x, u.y) | ((unsigned long long)pk2(u.z, u.w) << 32); } }
    }
}
typedef float f32x16 __attribute__((ext_vector_type(16)));
#define MFMA32(a, b, c) __builtin_amdgcn_mfma_f32_32x32x16_bf16((a), (b), (c), 0, 0, 0)
__device__ __forceinline__ bf16x8 ldfrag(const LAS bf16* base, int stride, int row, int k) { return *(const LAS bf16x8*)(base + row * stride + k); }
__device__ __forceinline__ int crow(int reg, int hi) { return (reg & 3) + 8 * (reg >> 2) + 4 * hi; }
__device__ __forceinline__ v4u pack8(const float* f) { v4u o; o.x = pk2(f[0], f[1]); o.y = pk2(f[2], f[3]); o.z = pk2(f[4], f[5]); o.w = pk2(f[6], f[7]); return o; }
__device__ __forceinline__ float fsigmoid(float x) { return __builtin_amdgcn_rcpf(1.f + __expf(-x)); }
constexpr int RG_CH = 128, RG_NCH = SEQ / RG_CH;
template <bool FINAL> __device__ __forceinline__ void rg_pass(Frame& F) {
    PHASE_IDS
    const int r = lane & 31, hh = lane >> 5;
    LAS bf16* XT = (LAS bf16*)(F.lds + wave * 9216);
    const int gw = F.vcu * NWAVES + wave, NGW = F.G * NWAVES;
    const bf16* PROJ = WSP(bf16, WS_PROJ); const bf16* RGWT = WSP(bf16, WS_RGWT);
    for (int wu = gw; wu < BATCH * 8 * 2 * RG_NCH; wu += NGW) {
        const int ct = wu & 1, n = (wu >> 1) & 7, ch = (wu >> 4) & (RG_NCH - 1), b = wu >> 9;
        const int c = n * 64 + 32 * ct + r, cc = n * 64 + lane;
        bf16x8 bwa[4], bwx[4], idn[4];
#pragma unroll
        for (int ks = 0; ks < 4; ++ks) { bwa[ks] = *(const bf16x8*)(RGWT + ((size_t)(0 * 8 + n) * 64 + 32 * ct + r) * 64 + 16 * ks + 8 * hh); bwx[ks] = *(const bf16x8*)(RGWT + ((size_t)(1 * 8 + n) * 64 + 32 * ct + r) * 64 + 16 * ks + 8 * hh);
            const int m = 32 * ct + r - 16 * ks - 8 * hh;
#pragma unroll
            for (int jj = 0; jj < 8; ++jj) idn[ks][jj] = (m == jj) ? (short)0x3F80 : (short)0; }
        const float ba = inp(10)[c], bx = inp(12)[c], lsl8 = 8.0f * logsigmoid_f(inp(13)[c]);
        const float cw0 = inp(7)[cc], cw1 = inp(7)[512 + cc], cw2 = inp(7)[1024 + cc], cw3 = inp(7)[1536 + cc], cbv = inp(8)[cc];
        float h = FINAL ? WSP(float, WS_RGC)[(size_t)(b * RG_NCH + ch) * 512 + c] : 0.f, P = 1.f;
#pragma unroll 1
        for (int half = 0; half < 2; ++half) {
            const int tb = ch * RG_CH + 64 * half; const size_t row0 = (size_t)b * SEQ + tb;
            { const bf16* xr = PROJ + row0 * N0 + cc; float x0 = 0.f, x1 = 0.f, x2 = 0.f;
              if (tb > 0) { x0 = bf2f(xr[-3 * N0]); x1 = bf2f(xr[-2 * N0]); x2 = bf2f(xr[-1 * N0]); }
#pragma unroll 8
              for (int t = 0; t < 64; ++t) { const float x3 = bf2f(xr[(size_t)t * N0]); XT[t * 72 + lane] = (bf16)f2bf(cbv + cw0 * x0 + cw1 * x1 + cw2 * x2 + cw3 * x3); x0 = x1; x1 = x2; x2 = x3; } }
            asm volatile("s_waitcnt lgkmcnt(0)" ::: "memory");
#pragma unroll 1
            for (int tile = 0; tile < 2; ++tile) {
                const size_t trow = row0 + 32 * tile;
                float yv[16];
                if (FINAL) {
#pragma unroll
                    for (int q = 0; q < 16; ++q) yv[q] = bf2f(PROJ[(trow + crow(q, hh)) * N0 + 512 + c]); }
                f32x16 aa = {}, uu = {}, xi = {};
#pragma unroll
                for (int ks = 0; ks < 4; ++ks) { const bf16x8 af = ldfrag(XT, 72, 32 * tile + r, 16 * ks + 8 * hh); aa = MFMA32(af, bwa[ks], aa); uu = MFMA32(af, bwx[ks], uu); xi = MFMA32(af, idn[ks], xi); }
#pragma unroll
                for (int q = 0; q < 16; ++q) { const float rg = fsigmoid(aa[q] + ba), ig = fsigmoid(uu[q] + bx); const float a = __expf(lsl8 * rg); aa[q] = a; uu[q] = sqrtf(fmaxf(1.f - a * a, 0.f)) * (ig * xi[q]); }
                float GA[4], GB[4], PA[4], PB[4];
#pragma unroll
                for (int g = 0; g < 4; ++g) { float A = aa[4 * g], Bv = uu[4 * g];
#pragma unroll
                    for (int e = 1; e < 4; ++e) { A *= aa[4 * g + e]; Bv = aa[4 * g + e] * Bv + uu[4 * g + e]; }
                    GA[g] = A; GB[g] = Bv; PA[g] = __shfl_xor(A, 32); PB[g] = __shfl_xor(Bv, 32); }
                float hs[4];
#pragma unroll
                for (int g = 0; g < 4; ++g) { if (hh == 0) { hs[g] = h; h = GA[g] * h + GB[g]; h = PA[g] * h + PB[g]; } else { h = PA[g] * h + PB[g]; hs[g] = h; h = GA[g] * h + GB[g]; }
                    if (!FINAL) P *= GA[g] * PA[g]; }
                if (FINAL) {
#pragma unroll
                    for (int g = 0; g < 4; ++g) { float hv = hs[g];
#pragma unroll
                        for (int e = 0; e < 4; ++e) { const int q = 4 * g + e; hv = aa[q] * hv + uu[q]; const float y = yv[q]; const float th = 1.f - 2.f * __builtin_amdgcn_rcpf(1.f + __expf(1.5957691216057308f * (y + 0.044715f * y * y * y)));
                            WSP(bf16, WS_MIX)[(trow + crow(q, hh)) * D + c] = (bf16)f2bf(hv * 0.5f * y * (1.f + th)); } } }
            }
            asm volatile("s_waitcnt lgkmcnt(0)" ::: "memory");
        }
        if (!FINAL && hh == 0) { WSP(float, WS_RGP)[(size_t)(b * RG_NCH + ch) * 512 + c] = P; WSP(float, WS_RGH)[(size_t)(b * RG_NCH + ch) * 512 + c] = h; }
    }
}
__device__ __forceinline__ void gla_pass_a(Frame& F) {
    PHASE_IDS
    const int r = lane & 31, hh = lane >> 5;
    LAS bf16* KET = (LAS bf16*)F.lds; LAS bf16* VT = (LAS bf16*)(F.lds + 9216); LAS float* ESUM = (LAS float*)(F.lds + 27648);
    const bf16* PROJ = WSP(bf16, WS_PROJ);
    for (int unit = F.vcu; unit < BATCH * 4 * 64; unit += F.G) {
        const int bh = unit >> 6, nch = unit & 63, b = bh >> 2, h = bh & 3; const size_t row0 = (size_t)b * SEQ + nch * 64;
        const int d = tid & 63, te = wave;
        float la[8], kk[8];
        { const bf16* p = PROJ + (row0 + 8 * te) * N0 + h * 64 + d;
#pragma unroll
          for (int i = 0; i < 8; ++i) { la[i] = logsigmoid_f(bf2f(p[(size_t)i * N0 + 2560])) * (1.f / 16.f); kk[i] = bf2f(p[(size_t)i * N0 + 1280]); }
#pragma unroll
          for (int i = 1; i < 8; ++i) la[i] += la[i - 1];
          ESUM[te * 64 + d] = la[7]; }
        { const int v = tid & 127, tq = tid >> 7; const bf16* p = PROJ + (row0 + 16 * tq) * N0 + 1536 + h * 128 + v; float vv[16];
#pragma unroll
          for (int i = 0; i < 16; ++i) vv[i] = bf2f(p[(size_t)i * N0]);
          *(LAS v4u*)(VT + v * 72 + 16 * tq) = pack8(vv); *(LAS v4u*)(VT + v * 72 + 16 * tq + 8) = pack8(vv + 8); }
        __syncthreads();
        { float pre = 0.f, bl = 0.f;
#pragma unroll
          for (int e = 0; e < 8; ++e) { const float sv = ESUM[e * 64 + d]; bl += sv; if (e < te) pre += sv; }
          float ke[8];
#pragma unroll
          for (int i = 0; i < 8; ++i) ke[i] = kk[i] * __expf(bl - (pre + la[i]));
          *(LAS v4u*)(KET + d * 72 + 8 * te) = pack8(ke);
          if (te == 0) WSP(float, WS_GDEC)[(size_t)unit * 64 + d] = __expf(bl); }
        __syncthreads();
        { const int tm = wave >> 2, tn = wave & 3; f32x16 acc = {};
#pragma unroll
          for (int ks = 0; ks < 4; ++ks) acc = MFMA32(ldfrag(KET, 72, 32 * tm + r, 16 * ks + 8 * hh), ldfrag(VT, 72, 32 * tn + r, 16 * ks + 8 * hh), acc);
          float* kvp = WSP(float, WS_GKV) + (size_t)unit * 8192 + 32 * tn + r;
#pragma unroll
          for (int q = 0; q < 16; ++q) kvp[(32 * tm + crow(q, hh)) * 128] = acc[q]; }
        __syncthreads();
    }
}
__device__ __forceinline__ void gla_pass_c(Frame& F) {
    PHASE_IDS
    const int r = lane & 31, hh = lane >> 5;
    LAS bf16* QD = (LAS bf16*)F.lds; LAS bf16* KD = (LAS bf16*)(F.lds + 9216); LAS bf16* ATT = (LAS bf16*)(F.lds + 18432); LAS bf16* VT = (LAS bf16*)(F.lds + 27648); LAS bf16* ST = (LAS bf16*)(F.lds + 46080);
    LAS bf16* GT = (LAS bf16*)(F.lds + 64512); LAS float* ESUM = (LAS float*)(F.lds + 81408); LAS float* PART = (LAS float*)(F.lds + 83456);
    const bf16* PROJ = WSP(bf16, WS_PROJ);
    for (int unit = F.vcu; unit < BATCH * 4 * 64; unit += F.G) {
        const int bh = unit >> 6, nch = unit & 63, b = bh >> 2, h = bh & 3; const size_t row0 = (size_t)b * SEQ + nch * 64;
        const int d = tid & 63, te = wave;
        float la[8], kk[8], qq[8];
        { const bf16* p = PROJ + (row0 + 8 * te) * N0 + h * 64 + d;
#pragma unroll
          for (int i = 0; i < 8; ++i) { la[i] = logsigmoid_f(bf2f(p[(size_t)i * N0 + 2560])) * (1.f / 16.f); kk[i] = bf2f(p[(size_t)i * N0 + 1280]); qq[i] = bf2f(p[(size_t)i * N0 + 1024]) * 0.125f; }
#pragma unroll
          for (int i = 1; i < 8; ++i) la[i] += la[i - 1];
          ESUM[te * 64 + d] = la[7]; }
        { const int v = tid & 127, tq = tid >> 7; const bf16* p = PROJ + (row0 + 16 * tq) * N0 + 1536 + h * 128 + v; float vv[16];
#pragma unroll
          for (int i = 0; i < 16; ++i) vv[i] = bf2f(p[(size_t)i * N0]);
          *(LAS v4u*)(VT + v * 72 + 16 * tq) = pack8(vv); *(LAS v4u*)(VT + v * 72 + 16 * tq + 8) = pack8(vv + 8);
          const float* sp = WSP(float, WS_GKV) + (size_t)unit * 8192 + (16 * tq) * 128 + v;
#pragma unroll
          for (int i = 0; i < 16; ++i) vv[i] = sp[i * 128];
          *(LAS v4u*)(ST + v * 72 + 16 * tq) = pack8(vv); *(LAS v4u*)(ST + v * 72 + 16 * tq + 8) = pack8(vv + 8); }
        { const int t = tid >> 3, vc = tid & 7; const v4u* gp = (const v4u*)(PROJ + (row0 + t) * N0 + 2048 + h * 128 + 16 * vc); const v4u g0 = gp[0], g1 = gp[1];
          LAS unsigned long long* dst = (LAS unsigned long long*)(GT + t * 132 + 16 * vc);
          dst[0] = (unsigned long long)g0.x | ((unsigned long long)g0.y << 32); dst[1] = (unsigned long long)g0.z | ((unsigned long long)g0.w << 32);
          dst[2] = (unsigned long long)g1.x | ((unsigned long long)g1.y << 32); dst[3] = (unsigned long long)g1.z | ((unsigned long long)g1.w << 32); }
        __syncthreads();
        { float pre = 0.f;
#pragma unroll
          for (int e = 0; e < 8; ++e) { const float sv = ESUM[e * 64 + d]; if (e < te) pre += sv; }
#pragma unroll
          for (int i = 0; i < 8; ++i) { const float bc = pre + la[i]; QD[(8 * te + i) * 72 + d] = (bf16)f2bf(qq[i] * __expf(bc)); KD[(8 * te + i) * 72 + d] = (bf16)f2bf(kk[i] * __expf(-bc)); } }
        __syncthreads();
        if (wave < 3) { const int tm = (wave + 1) >> 1, tn = wave >> 1;
          f32x16 acc = {};
#pragma unroll
          for (int ks = 0; ks < 4; ++ks) acc = MFMA32(ldfrag(QD, 72, 32 * tm + r, 16 * ks + 8 * hh), ldfrag(KD, 72, 32 * tn + r, 16 * ks + 8 * hh), acc);
#pragma unroll
          for (int q = 0; q < 16; ++q) { const int t = 32 * tm + crow(q, hh), s_ = 32 * tn + r; ATT[t * 72 + s_] = (bf16)f2bf((t >= s_) ? acc[q] : 0.f); } }
        __syncthreads();
        const int tm = wave >> 1, tn = wave & 1;
        f32x16 acc = {};
        if (tn == 0) {
#pragma unroll
            for (int ks = 0; ks < 2; ++ks) acc = MFMA32(ldfrag(VT, 72, 32 * tm + r, 16 * ks + 8 * hh), ldfrag(ATT, 72, r, 16 * ks + 8 * hh), acc);
        } else {
#pragma unroll
            for (int ks = 0; ks < 4; ++ks) acc = MFMA32(ldfrag(VT, 72, 32 * tm + r, 16 * ks + 8 * hh), ldfrag(ATT, 72, 32 + r, 16 * ks + 8 * hh), acc);
        }
#pragma unroll
        for (int ks = 0; ks < 4; ++ks) acc = MFMA32(ldfrag(ST, 72, 32 * tm + r, 16 * ks + 8 * hh), ldfrag(QD, 72, 32 * tn + r, 16 * ks + 8 * hh), acc);
        { float ssq = 0.f;
#pragma unroll
          for (int q = 0; q < 16; ++q) ssq += acc[q] * acc[q];
          ssq += __shfl_xor(ssq, 32); if (hh == 0) PART[tm * 64 + 32 * tn + r] = ssq; }
        __syncthreads();
        { const int t = 32 * tn + r; const float tot = (PART[t] + PART[64 + t]) + (PART[128 + t] + PART[192 + t]); const float ri = 1.f / sqrtf(tot * (1.f / 128.f) + 1e-6f);
          const float* gn = inp(16) + h * 128 + 32 * tm + 4 * hh;
#pragma unroll
          for (int g = 0; g < 4; ++g) { const f32x4 gv = *(const f32x4*)(gn + 8 * g);
#pragma unroll
              for (int e = 0; e < 4; ++e) { const int q = 4 * g + e, v = 32 * tm + crow(q, hh); const float gg = bf2f(GT[t * 132 + v]); GT[t * 132 + v] = (bf16)f2bf(acc[q] * ri * gv[e] * (gg * fsigmoid(gg))); } } }
        __syncthreads();
        { const int t = tid >> 3, vc = tid & 7; const LAS unsigned long long* src = (const LAS unsigned long long*)(GT + t * 132 + 16 * vc); const unsigned long long a0 = src[0], a1 = src[1], a2 = src[2], a3 = src[3];
          v4u* op = (v4u*)(WSP(bf16, WS_MIX) + (row0 + t) * D + 512 + h * 128 + 16 * vc);
          op[0] = (v4u){(unsigned)a0, (unsigned)(a0 >> 32), (unsigned)a1, (unsigned)(a1 >> 32)}; op[1] = (v4u){(unsigned)a2, (unsigned)(a2 >> 32), (unsigned)a3, (unsigned)(a3 >> 32)}; }
        __syncthreads();
    }
}
__device__ __forceinline__ void chunk_scan_phase(Frame& F) {
    PHASE_IDS
    const int gt = F.vcu * NWAVES * 64 + tid, NGT = F.G * NWAVES * 64;
    float* KV = WSP(float, WS_GKV); const float* DEC = WSP(float, WS_GDEC);
    for (int idx = gt; idx < 32 * 8192; idx += NGT) {
        const int bh = idx >> 13, r = idx & 8191, dk = r >> 7; float S = 0.f;
#pragma unroll 1
        for (int n0 = 0; n0 < 64; n0 += 8) { float kv[8], dc[8];
#pragma unroll
            for (int q = 0; q < 8; ++q) { kv[q] = KV[((size_t)(bh * 64 + n0 + q)) * 8192 + r]; dc[q] = DEC[(bh * 64 + n0 + q) * 64 + dk]; }
#pragma unroll
            for (int q = 0; q < 8; ++q) { KV[((size_t)(bh * 64 + n0 + q)) * 8192 + r] = S; S = dc[q] * S + kv[q]; } }
    }
    const float* P = WSP(float, WS_RGP); const float* H = WSP(float, WS_RGH); float* C = WSP(float, WS_RGC);
    for (int idx = gt; idx < BATCH * 512; idx += NGT) {
        const int b = idx >> 9, c = idx & 511; float h = 0.f;
#pragma unroll 1
        for (int n0 = 0; n0 < RG_NCH; n0 += 8) { float pv[8], hv[8];
#pragma unroll
            for (int q = 0; q < 8; ++q) { pv[q] = P[(size_t)(b * RG_NCH + n0 + q) * 512 + c]; hv[q] = H[(size_t)(b * RG_NCH + n0 + q) * 512 + c]; }
#pragma unroll
            for (int q = 0; q < 8; ++q) { C[(size_t)(b * RG_NCH + n0 + q) * 512 + c] = h; h = pv[q] * h + hv[q]; } }
    }
}
__device__ __forceinline__ void fcum_phase(Frame& F) {
    PHASE_IDS
    const int gw = F.vcu * NWAVES + wave, NGW = F.G * NWAVES;
    for (int wu = gw; wu < BATCH * 16 * 16; wu += NGW) {
        const int bh = wu >> 4, seg = wu & 15, b = bh >> 4, h = bh & 15; const float bf = inp(19)[h]; const float* fl = WSP(float, WS_FL) + (size_t)b * SEQ * 16 + h;
        float pre = 0.f;
#pragma unroll 4
        for (int t0 = 0; t0 < seg * 256; t0 += 64) pre += logsigmoid_f(fl[(size_t)(t0 + lane) * 16] + bf);
        pre = wave_sum(pre);
        float v[4]; float s = 0.f;
#pragma unroll
        for (int e = 0; e < 4; ++e) { v[e] = logsigmoid_f(fl[(size_t)(seg * 256 + 4 * lane + e) * 16] + bf); s += v[e]; }
        float incl = s;
#pragma unroll
        for (int o = 1; o < 64; o <<= 1) { const float t = __shfl_up(incl, o); if (lane >= o) incl += t; }
        float run = pre + incl - s; f32x4 o4;
#pragma unroll
        for (int e = 0; e < 4; ++e) { run += v[e]; o4[e] = -1.4426950408889634f * run; }
        *(f32x4*)(WSP(float, WS_KB) + (size_t)bh * SEQ + seg * 256 + 4 * lane) = o4;
    }
}
struct Args { const float* in[27]; float* out; unsigned char* ws; };
__global__ void __launch_bounds__(NWAVES * 64, 2) mega_fwd(Args args) {
    extern __shared__ __attribute__((aligned(16))) unsigned char lds[];
    Frame F;
    F.lds = (LAS unsigned char*)lds; F.MISC = (volatile LAS unsigned*)(F.lds + MISC_OFF);
    F.G = gridDim.x; { const int bx = blockIdx.x; F.vcu = (F.G % 8 == 0) ? (bx % 8) * (F.G / 8) + bx / 8 : bx; }
    F.ws = args.ws; F.ctl = (gu32*)(args.ws + WS_CTL);
    for (int u = threadIdx.x; u < (LDS_BYTES - LDSCTL_OFF) / 4; u += NWAVES * 64) ((LAS unsigned*)(F.lds + LDSCTL_OFF))[u] = 0u;
    __syncthreads();
    XcdBarrier bar = xcd_barrier_post((unsigned*)(F.ctl + CW_BAR), F.MISC + 8);
#ifdef PROBE_A0
    unsigned long long* const ts_ = (unsigned long long*)(F.ctl + 2048); int tsn_ = 0;
#define TS() do { if (blockIdx.x == 0 && threadIdx.x == 0) ts_[tsn_] = __builtin_amdgcn_s_memrealtime(); ++tsn_; } while (0)
#else
#define TS() do { } while (0)
#endif
    TS();
#define GRID_BAR() do { xcd_barrier(bar); TS(); } while (0)
#define MODP(l, s) (WSP(float, WS_MOD) + (size_t)((l) * 2 + (s)) * BATCH * 3072)
#define GEMM_MULTI(EpiT, E, Aop, Bop, Nn, Kk) do { pg8::Gemm g_{(const pg8::bf16_t*)(Aop), (const pg8::bf16_t*)(Bop), M, (Nn), (Kk)}; pg8::StaticOrder S_; S_.init(M, (Nn), F.G, (int)blockIdx.x); \
        pg8::gemm_phase<EpiT, pg8::StaticOrder, PG8_ALIGN, PG8_SP2>(F.lds, g_, S_, (E)); } while (0)

    p0a_phase(F);
    cg::this_grid().sync(); TS();
    modulate_phase(F, inp(0), MODP(0, 0), WSP(bf16, WS_U));
    GRID_BAR();
    { pg8::EpiBf16<0> E{(pg8::bf16_t*)WSP(bf16, WS_PROJ), N0, WSP(float, WS_BIAS0), 0, 0, 1.f}; GEMM_MULTI(pg8::EpiBf16<0>, E, WSP(bf16, WS_U), WSP(bf16, WS_WIN0), N0, D); }
    GRID_BAR();
    rg_pass<false>(F); __syncthreads(); gla_pass_a(F);
    GRID_BAR();
    chunk_scan_phase(F);
    GRID_BAR();
    rg_pass<true>(F); __syncthreads(); gla_pass_c(F);
    GRID_BAR();
    { pg8::EpiResid E{inp(0), ((float*)inp(27)), nullptr, MODP(0, 0)}; GEMM_MULTI(pg8::EpiResid, E, WSP(bf16, WS_MIX), WSP(bf16, WS_WOUT0), D, D); }
    GRID_BAR();
    ln_phase<true>(F, ((float*)inp(27)), inp(4), inp(5), MODP(0, 1), WSP(bf16, WS_U));
    GRID_BAR();
    { pg8::EpiBf16<2> E{(pg8::bf16_t*)WSP(bf16, WS_PROJ), FF, inp(24), 0, 0, 1.f}; GEMM_MULTI(pg8::EpiBf16<2>, E, WSP(bf16, WS_U), WSP(bf16, WS_W1_0), FF, D); }
    GRID_BAR();
    { pg8::EpiResid E{((float*)inp(27)), ((float*)inp(27)), inp(26), MODP(0, 1)}; GEMM_MULTI(pg8::EpiResid, E, WSP(bf16, WS_PROJ), WSP(bf16, WS_W2_0), D, FF); }
    GRID_BAR();
    ln_phase<true>(F, ((float*)inp(27)), inp(4) + D, inp(5) + D, MODP(1, 0), WSP(bf16, WS_U));
    GRID_BAR();
    { pg8::EpiQKVG E{(pg8::bf16_t*)WSP(bf16, WS_PROJ), QKVG_STRIDE, WSP(float, WS_FL), inp(20), inp(21), attn_body::C2}; GEMM_MULTI(pg8::EpiQKVG, E, WSP(bf16, WS_U), WSP(bf16, WS_WIN1), N1, D); }
    GRID_BAR();
    fcum_phase(F);
    GRID_BAR();
    { const attn_body::AttnTensors AT{(const attn_body::bf16*)WSP(bf16, WS_PROJ), (const attn_body::bf16*)(WSP(bf16, WS_PROJ) + QKVG_STRIDE), (const attn_body::bf16*)(WSP(bf16, WS_PROJ) + 2 * QKVG_STRIDE),
                                      (attn_body::bf16*)WSP(bf16, WS_PROJ), (const attn_body::bf16*)(WSP(bf16, WS_PROJ) + 3 * QKVG_STRIDE), WSP(float, WS_KB),
#ifdef PROBE_A0
                                      (unsigned long long*)(F.ctl + 2048)
#else
                                      nullptr
#endif
      };
      const attn_body::StaticOrder S((int)F.G, (int)blockIdx.x);
      attn_body::attn_phase<attn_body::StaticOrder, 20>((char*)lds, AT, S); }
    GRID_BAR();
    { pg8::EpiResid E{((float*)inp(27)), ((float*)inp(27)), nullptr, MODP(1, 0)}; GEMM_MULTI(pg8::EpiResid, E, WSP(bf16, WS_PROJ), WSP(bf16, WS_WOUT1), D, D); }
    GRID_BAR();
    ln_phase<true>(F, ((float*)inp(27)), inp(4) + 2 * D, inp(5) + 2 * D, MODP(1, 1), WSP(bf16, WS_U));
    GRID_BAR();
    { pg8::EpiBf16<2> E{(pg8::bf16_t*)WSP(bf16, WS_PROJ), FF, inp(24) + FF, 0, 0, 1.f}; GEMM_MULTI(pg8::EpiBf16<2>, E, WSP(bf16, WS_U), WSP(bf16, WS_W1_1), FF, D); }
    GRID_BAR();
    { pg8::EpiResid E{((float*)inp(27)), ((float*)inp(27)), inp(26) + D, MODP(1, 1)}; GEMM_MULTI(pg8::EpiResid, E, WSP(bf16, WS_PROJ), WSP(bf16, WS_W2_1), D, FF); }
    GRID_BAR();
    ln_phase<false>(F, ((float*)inp(27)), inp(4) + 3 * D, inp(5) + 3 * D, nullptr, WSP(bf16, WS_U));
#ifdef PROBE_A0
    asm volatile("s_waitcnt vmcnt(0)" ::: "memory"); __syncthreads(); TS();
    if (blockIdx.x == 0) {
        __syncthreads();
        float* o = (float*)inp(27);
        const float ta = (float)(ts_[PROBE_A1] - ts_[PROBE_A0]) * 0.01f, tr = (float)(ts_[PROBE_R1] - ts_[PROBE_R0]) * 0.01f;
        const float dl = sqrtf(tr / 4000.f);
        for (int i = threadIdx.x; i < 8192; i += NWAVES * 64) o[i] += (i == 0) ? (ta / 64.f) : dl;
    }
#endif
}

extern "C" void kernel_launch(void* const* d_in, const int* in_sizes, int n_in, void* d_out, int out_size, void* d_ws, size_t ws_size, hipStream_t stream) {
    static int grid = 0;
    if (grid == 0) {
        if (n_in != 27 || in_sizes[0] != M * D || out_size != M * D || ws_size < WS_END) { fprintf(stderr, "kernel_launch: unexpected shapes (n_in %d, in0 %d, out %d, ws %zu); nothing launched\n", n_in, n_in > 0 ? in_sizes[0] : -1, out_size, ws_size); grid = -1; return; }
        int dev = 0, cus = 0, per_cu = 0;
        if (hipGetDevice(&dev) != hipSuccess || hipDeviceGetAttribute(&cus, hipDeviceAttributeMultiprocessorCount, dev) != hipSuccess) { grid = -1; return; }
        if (hipFuncSetAttribute((const void*)mega_fwd, hipFuncAttributeMaxDynamicSharedMemorySize, LDS_BYTES) != hipSuccess) { fprintf(stderr, "kernel_launch: hipFuncSetAttribute failed\n"); grid = -1; return; }
        if (hipOccupancyMaxActiveBlocksPerMultiprocessor(&per_cu, (const void*)mega_fwd, NWAVES * 64, LDS_BYTES) != hipSuccess || per_cu < 1) { fprintf(stderr, "kernel_launch: occupancy query says %d blocks per CU; nothing launched\n", per_cu); (void)hipGetLastError(); grid = -1; return; }
        grid = cus * per_cu;
    }
    if (grid < 0) return;
    if (hipMemsetAsync((char*)d_ws + WS_CTL, 0, CTL_ZERO_BYTES, stream) != hipSuccess) { fprintf(stderr, "kernel_launch: memset failed\n"); return; }
    Args a{};
    for (int i = 0; i < 27; ++i) a.in[i] = (const float*)d_in[i];
    a.out = (float*)d_out; a.ws = (unsigned char*)d_ws;
    void* kargs[] = {&a};
    const hipError_t e = hipLaunchCooperativeKernel((const void*)mega_fwd, dim3(grid), dim3(NWAVES * 64), kargs, LDS_BYTES, stream);
    if (e != hipSuccess) fprintf(stderr, "kernel_launch: cooperative launch failed: %s (grid %d)\n", hipGetErrorString(e), grid);
}
```

```cpp
#include <hip/hip_runtime.h>
#include <hip/hip_cooperative_groups.h>
#include <cstdio>
#include <cstdint>

namespace pg8 {
#define PG8_LAS __attribute__((address_space(3)))
typedef unsigned short bf16_t;
typedef short bf16x8 __attribute__((ext_vector_type(8)));
typedef float f32x4 __attribute__((ext_vector_type(4)));
typedef unsigned u32x4 __attribute__((ext_vector_type(4)));
constexpr int BM = 256, BK = 64, HALF = 128, HTB = HALF * BK * 2  , STAGE_BYTES = 8 * HTB, NXCD = 8, WGM = 8;

__host__ __device__ __forceinline__ int lds_byte(int r, int c) { const int st = (r >> 4) * 2 + (c >> 5), rr = r & 15, cc = c & 31, ob = rr * 64 + cc * 2; return st * 1024 + (ob ^ (((ob >> 9) & 1) << 5)); }
__host__ __device__ __forceinline__ void stage_rc(int b, int& R, int& C) { const int st = b / 1024, sb = b % 1024, swz = sb ^ (((sb >> 9) & 1) << 5); R = (st >> 1) * 16 + swz / 64; C = (st & 1) * 32 + (swz % 64) / 2; }
__host__ __device__ __forceinline__ int perm32(int rho) { const int n = rho >> 4, i = rho & 15; return 8 * (i >> 2) + 4 * n + (i & 3); }

struct Unit { int pm, pn; };
struct Gemm { const bf16_t* A; const bf16_t* Bt; int M, N, K; };

struct StaticOrder {
    int nM, nN, nwg, G, c;
    __host__ __device__ void init(int M, int N, int G_, int c_) { nM = M / BM; nN = N / BM; nwg = nM * nN; G = G_; c = c_; }
    __host__ __device__ bool next(int i, Unit& u) const {
        const long L = (long)i * G + c; if (L >= nwg) return false;
        int wgid = (int)L; { const int q = nwg / NXCD, r = nwg % NXCD, xcd = wgid % NXCD, off = wgid / NXCD; wgid = (xcd < r ? xcd * (q + 1) : r * (q + 1) + (xcd - r) * q) + off; }
        const int nig = WGM * nN, gid = wgid / nig, fm = gid * WGM, gsz = (nM - fm) < WGM ? (nM - fm) : WGM;
        u.pm = fm + ((wgid % nig) % gsz); u.pn = (wgid % nig) / gsz; return true;
    }
    __device__ __forceinline__ void a_ready(const Unit&) const {}
    __device__ __forceinline__ void done(const Unit&) const {}
};

__device__ __forceinline__ unsigned cvt_pk_bf16(float lo, float hi) { unsigned r; asm volatile("v_cvt_pk_bf16_f32 %0, %1, %2" : "=v"(r) : "v"(lo), "v"(hi)); return r; }
typedef float f32x2 __attribute__((ext_vector_type(2)));
__device__ __forceinline__ f32x2 gelu_pk(f32x2 v) {
    const f32x2 av = __builtin_elementwise_abs(v), d = av * 0.2316418882f + 1.0f;
    f32x2 t; t.x = __builtin_amdgcn_rcpf(d.x); t.y = __builtin_amdgcn_rcpf(d.y);
    f32x2 q = t * 0.5307027145f + (-0.7265760135f); q = q * t + 0.7107068705f; q = q * t + (-0.142248368f); q = q * t + 0.127414796f; q = q * t;
    const f32x2 s = (v * v) * (-0.72134752044f);
    f32x2 e; e.x = __builtin_amdgcn_exp2f(s.x); e.y = __builtin_amdgcn_exp2f(s.y);
    const f32x2 m = v * (q * e), r = v - m;
    f32x2 o; o.x = v.x < 0.f ? m.x : r.x; o.y = v.y < 0.f ? m.y : r.y; return o;
}

template <int ACT  > struct EpiBf16 {
    static constexpr bool PERM = true, AFTER_DRAIN = false, HEADPERM = false; static_assert(ACT == 0 || ACT == 1 || ACT == 2, "EpiBf16: ACT is 0 (none), 1 (gelu_pk) or 2 (relu^2)");
    bf16_t* O; int ldc; const float* bias; int split_cols; size_t split_stride; float scale0;
    __device__ __forceinline__ void operator()(const f32x4 (&acc)[2][2][4][2], const Unit& u, int wr, int wc, int fr, int fq) const {
        const int row0 = u.pm * BM + wr * 64 + fr; int colt = u.pn * BM; bf16_t* base = O;
        float sc = 1.f; if (split_cols) { const int t = colt / split_cols; base += (size_t)t * split_stride; colt -= t * split_cols; if (t == 0) sc = scale0; }
        const int col0 = colt + wc * 32 + 8 * fq, bcol0 = u.pn * BM + wc * 32 + 8 * fq;
        f32x4 bv[2][2];
#pragma unroll
        for (int bj = 0; bj < 2; ++bj)
#pragma unroll
            for (int n = 0; n < 2; ++n) bv[bj][n] = bias ? *(const f32x4*)(bias + bcol0 + bj * HALF + 4 * n) : (f32x4){0.f, 0.f, 0.f, 0.f};
#pragma unroll
        for (int ai = 0; ai < 2; ++ai)
#pragma unroll
            for (int m = 0; m < 4; ++m) { bf16_t* rowp = base + (size_t)(row0 + ai * HALF + m * 16) * ldc + col0;
#pragma unroll
                for (int bj = 0; bj < 2; ++bj) { f32x4 v0 = acc[ai][bj][m][0] + bv[bj][0], v1 = acc[ai][bj][m][1] + bv[bj][1];
                    if (ACT == 1) { f32x2 a = gelu_pk((f32x2){v0[0], v0[1]}), b = gelu_pk((f32x2){v0[2], v0[3]}), c = gelu_pk((f32x2){v1[0], v1[1]}), d = gelu_pk((f32x2){v1[2], v1[3]});
                        v0 = (f32x4){a.x, a.y, b.x, b.y}; v1 = (f32x4){c.x, c.y, d.x, d.y}; }
                    if (ACT == 2) { _Pragma("unroll") for (int e_ = 0; e_ < 4; ++e_) { const float a_ = fmaxf(v0[e_], 0.f), b_ = fmaxf(v1[e_], 0.f); v0[e_] = a_ * a_; v1[e_] = b_ * b_; } }
                    v0 = v0 * sc; v1 = v1 * sc; u32x4 w; w.x = cvt_pk_bf16(v0[0], v0[1]); w.y = cvt_pk_bf16(v0[2], v0[3]); w.z = cvt_pk_bf16(v1[0], v1[1]); w.w = cvt_pk_bf16(v1[2], v1[3]);
                    *(u32x4*)(rowp + bj * HALF) = w; } }
    }
};
typedef unsigned u32x2 __attribute__((ext_vector_type(2)));
struct EpiResid {
    static constexpr bool PERM = false, AFTER_DRAIN = false, HEADPERM = false;
    const float* base; float* out; const float* bias; const float* mod;
    __device__ __forceinline__ void operator()(const f32x4 (&acc)[2][2][4][2], const Unit& u, int wr, int wc, int fr, int fq) const {
        const int col0 = u.pn * BM + wc * 32 + 4 * fq; const float* mg = mod + (size_t)(u.pm >> 4) * 3072 + 2048;
        f32x4 gv[2][2], bv[2][2];
#pragma unroll
        for (int bj = 0; bj < 2; ++bj)
#pragma unroll
            for (int n = 0; n < 2; ++n) { gv[bj][n] = *(const f32x4*)(mg + col0 + bj * HALF + n * 16) + 1.0f; bv[bj][n] = bias ? *(const f32x4*)(bias + col0 + bj * HALF + n * 16) : (f32x4){0.f, 0.f, 0.f, 0.f}; }
#pragma unroll
        for (int ai = 0; ai < 2; ++ai)
#pragma unroll
            for (int m = 0; m < 4; ++m) { const size_t off = (size_t)(u.pm * BM + ai * HALF + wr * 64 + m * 16 + fr) * 1024 + col0;
#pragma unroll
                for (int bj = 0; bj < 2; ++bj)
#pragma unroll
                    for (int n = 0; n < 2; ++n) { const f32x4 bs = *(const f32x4*)(base + off + bj * HALF + n * 16);
                        *(f32x4*)(out + off + bj * HALF + n * 16) = bs * 1.41421356237309515f + gv[bj][n] * (acc[ai][bj][m][n] + bv[bj][n]); }
                if (m & 1) asm volatile("" ::: "memory"); }
    }
};
struct EpiQKVG {
    static constexpr bool PERM = true, AFTER_DRAIN = false, HEADPERM = true;
    bf16_t* qkvg; size_t stride; float* fl; const float* qg; const float* kg; float scale0;
    __device__ __forceinline__ void operator()(const f32x4 (&acc)[2][2][4][2], const Unit& u, int wr, int wc, int fr, int fq) const {
        const int row0 = u.pm * BM + wr * 64 + fr;
        if (u.pn == 16) {
            if (wc == 0 && fq < 2) {
#pragma unroll
                for (int ai = 0; ai < 2; ++ai)
#pragma unroll
                    for (int m = 0; m < 4; ++m) { float* p = fl + (size_t)(row0 + ai * HALF + m * 16) * 16 + 8 * fq; *(f32x4*)p = acc[ai][0][m][0]; *(f32x4*)(p + 4) = acc[ai][0][m][1]; }
            }
            return;
        }
        const int t = u.pn >> 2; bf16_t* dst = qkvg + (size_t)t * stride + (u.pn & 3) * 256 + wc * 64 + 8 * fq;
        f32x4 gv[2][2]; const float* gsrc = (t == 0) ? qg : kg; const float sc = (t == 0) ? scale0 : 1.0f;
        if (t < 2) {
#pragma unroll
            for (int bj = 0; bj < 2; ++bj)
#pragma unroll
                for (int n = 0; n < 2; ++n) gv[bj][n] = *(const f32x4*)(gsrc + 32 * bj + 8 * fq + 4 * n) * sc;
        }
#pragma unroll
        for (int ai = 0; ai < 2; ++ai)
#pragma unroll
            for (int m = 0; m < 4; ++m) { bf16_t* rowp = dst + (size_t)(row0 + ai * HALF + m * 16) * 1024;
                f32x4 v[2][2];
#pragma unroll
                for (int bj = 0; bj < 2; ++bj)
#pragma unroll
                    for (int n = 0; n < 2; ++n) v[bj][n] = acc[ai][bj][m][n];
                if (t < 2) { float ss = 0.f;
#pragma unroll
                    for (int bj = 0; bj < 2; ++bj)
#pragma unroll
                        for (int n = 0; n < 2; ++n) { const f32x4 x = v[bj][n]; ss += (x[0] * x[0] + x[1] * x[1]) + (x[2] * x[2] + x[3] * x[3]); }
                    ss += __shfl_xor(ss, 16); ss += __shfl_xor(ss, 32);
                    const float ri = 1.0f / sqrtf(ss * (1.0f / 64.0f) + 1e-6f);
#pragma unroll
                    for (int bj = 0; bj < 2; ++bj)
#pragma unroll
                        for (int n = 0; n < 2; ++n) v[bj][n] = v[bj][n] * ri * gv[bj][n]; }
#pragma unroll
                for (int bj = 0; bj < 2; ++bj) { u32x4 w; w.x = cvt_pk_bf16(v[bj][0][0], v[bj][0][1]); w.y = cvt_pk_bf16(v[bj][0][2], v[bj][0][3]); w.z = cvt_pk_bf16(v[bj][1][0], v[bj][1][1]); w.w = cvt_pk_bf16(v[bj][1][2], v[bj][1][3]);
                    *(u32x4*)(rowp + 32 * bj) = w; } }
    }
};

template <class Epi, class Sched, bool ALIGN_EPI = false, bool SP2 = false>
__device__ __forceinline__ void gemm_phase(PG8_LAS unsigned char* lds, const Gemm g, const Sched& S, const Epi& E) {
    int tid_g_ = threadIdx.x; asm volatile("" : "+v"(tid_g_)); const int tid = tid_g_, wid = __builtin_amdgcn_readfirstlane(tid >> 6), lane = tid & 63, wr = wid >> 2, wc = wid & 3, fr = lane & 15, fq = lane >> 4;
    const int K = g.K, nt = K / BK;
    unsigned voffA[2], voffB[2];
#pragma unroll
    for (int i = 0; i < 2; ++i) { int R, C; stage_rc(tid * 16 + i * 8192, R, C); const int Rb = Epi::HEADPERM ? (64 * (R >> 5) + perm32(R & 31)) : (Epi::PERM ? ((R & ~31) + perm32(R & 31)) : R);
        voffA[i] = (unsigned)(R * K + C) * 2u; voffB[i] = (unsigned)(Rb * K + C) * 2u; }
    const size_t kstep = (size_t)(BK * 2);
    const size_t hstep = (size_t)HALF * K * 2;
    const size_t tstep = 2 * hstep; const size_t hstepB = Epi::HEADPERM ? (size_t)32 * K * 2 : hstep;
    const unsigned ldsw = (unsigned)wid * 1024u;
    const int aoff = lds_byte(wr * 64 + fr, fq * 8), boff = lds_byte(wc * 32 + fr, fq * 8);
#define PG8_SA(b, h) (((b) * 2 + (h)) * HTB)
#define PG8_SB(b, h) ((4 + (b) * 2 + (h)) * HTB)
#define PG8_STAGE(bufoff, gbase, voff) do { _Pragma("unroll") for (int _i = 0; _i < 2; ++_i) \
        __builtin_amdgcn_global_load_lds((const unsigned*)((const char*)(gbase) + (voff)[_i]), (PG8_LAS unsigned*)(lds + (bufoff) + ldsw + _i * 8192), 16, 0, 0); } while (0)
#define PG8_LDA(dst, b, h) do { _Pragma("unroll") for (int m = 0; m < 4; ++m) _Pragma("unroll") for (int k = 0; k < 2; ++k) dst[m][k] = *(const PG8_LAS bf16x8*)(lds + PG8_SA(b, h) + aoff + m * 2048 + k * 1024); } while (0)
#define PG8_LDB(dst, b, h) do { _Pragma("unroll") for (int n = 0; n < 2; ++n) _Pragma("unroll") for (int k = 0; k < 2; ++k) dst[n][k] = *(const PG8_LAS bf16x8*)(lds + PG8_SB(b, h) + boff + n * 2048 + k * 1024); } while (0)
#define PG8_MMA(ai, bj, At, Bt) do { __builtin_amdgcn_s_setprio(1); _Pragma("unroll") for (int m = 0; m < 4; ++m) _Pragma("unroll") for (int n = 0; n < 2; ++n) _Pragma("unroll") for (int k = 0; k < 2; ++k) \
        acc[ai][bj][m][n] = __builtin_amdgcn_mfma_f32_16x16x32_bf16(Bt[n][k], At[m][k], acc[ai][bj][m][n], 0, 0, 0); __builtin_amdgcn_s_setprio(0); } while (0)
#define PG8_WAIT_V(n) asm volatile("s_waitcnt vmcnt(" #n ")" ::: "memory")
#define PG8_WAIT_L(n) asm volatile("s_waitcnt lgkmcnt(" #n ")" ::: "memory")
#define PG8_BAR __builtin_amdgcn_s_barrier()
#define PG8_SCHED __builtin_amdgcn_sched_barrier(0)
    Unit cur, nxt; int ui = 0;
    if (!S.next(0, cur)) return;
    f32x4 acc[2][2][4][2];
#pragma unroll
    for (int a = 0; a < 2; ++a)
#pragma unroll
        for (int b = 0; b < 2; ++b)
#pragma unroll
            for (int m = 0; m < 4; ++m)
#pragma unroll
                for (int n = 0; n < 2; ++n) acc[a][b][m][n] = (f32x4){0.f, 0.f, 0.f, 0.f};
    bf16x8 At[4][2], B0[2][2], B1[2][2];
    const char* cA = (const char*)g.A + (size_t)cur.pm * tstep; const char* cB = (const char*)g.Bt + (size_t)cur.pn * tstep;
    S.a_ready(cur);
    if constexpr (SP2) {
        PG8_STAGE(PG8_SB(0, 0), cB, voffB); PG8_STAGE(PG8_SB(0, 1), cB + hstepB, voffB); PG8_STAGE(PG8_SA(0, 0), cA, voffA); PG8_STAGE(PG8_SA(0, 1), cA + hstep, voffA);
        if (wr == 1) PG8_BAR;
        PG8_WAIT_V(2); PG8_BAR;
        PG8_STAGE(PG8_SB(1, 0), cB + kstep, voffB); PG8_STAGE(PG8_SA(1, 0), cA + kstep, voffA); PG8_STAGE(PG8_SB(1, 1), cB + hstepB + kstep, voffB);
        PG8_WAIT_V(6); PG8_BAR;
    } else {
        PG8_STAGE(PG8_SB(0, 0), cB, voffB); PG8_STAGE(PG8_SA(0, 0), cA, voffA); PG8_STAGE(PG8_SB(0, 1), cB + hstepB, voffB); PG8_STAGE(PG8_SA(0, 1), cA + hstep, voffA);
        if (wr == 1) PG8_BAR;
        PG8_WAIT_V(4); PG8_BAR;
        PG8_STAGE(PG8_SB(1, 0), cB + kstep, voffB); PG8_STAGE(PG8_SA(1, 0), cA + kstep, voffA); PG8_STAGE(PG8_SB(1, 1), cB + hstepB + kstep, voffB);
        PG8_WAIT_V(6); PG8_BAR;
    }
    for (;;) {
        const bool has_next = S.next(ui + 1, nxt);
        const char* nA = has_next ? (const char*)g.A + (size_t)nxt.pm * tstep : cA; const char* nB = has_next ? (const char*)g.Bt + (size_t)nxt.pn * tstep : cB;
        for (int t = 0; t < nt; t += 2) {
            const bool last = (t == nt - 2);
            const char* a1 = cA + (size_t)(t + 1) * kstep;
            const char* a2 = last ? nA : cA + (size_t)(t + 2) * kstep; const char* b2 = last ? nB : cB + (size_t)(t + 2) * kstep;
            const char* a3 = a2 + kstep; const char* b3 = b2 + kstep;
            if (last && has_next) S.a_ready(nxt);
            if constexpr (SP2) {
            PG8_LDB(B0, 0, 0); PG8_LDB(B1, 0, 1); PG8_SCHED; PG8_LDA(At, 0, 0); PG8_STAGE(PG8_SA(1, 1), a1 + hstep, voffA);
            PG8_WAIT_V(8); PG8_WAIT_L(0); PG8_BAR; PG8_MMA(0, 0, At, B0); PG8_MMA(0, 1, At, B1); PG8_BAR; PG8_SCHED;
            PG8_LDA(At, 0, 1); PG8_STAGE(PG8_SB(0, 0), b2, voffB); PG8_STAGE(PG8_SB(0, 1), b2 + hstepB, voffB); PG8_STAGE(PG8_SA(0, 0), a2, voffA);
            PG8_WAIT_V(8); PG8_WAIT_L(0); PG8_BAR; PG8_MMA(1, 0, At, B0); PG8_MMA(1, 1, At, B1); PG8_BAR; PG8_SCHED;
            PG8_LDB(B0, 1, 0); PG8_LDB(B1, 1, 1); PG8_SCHED; PG8_LDA(At, 1, 0); PG8_STAGE(PG8_SA(0, 1), a2 + hstep, voffA);
            PG8_WAIT_V(8); PG8_WAIT_L(0); PG8_BAR; PG8_MMA(0, 0, At, B0); PG8_MMA(0, 1, At, B1); PG8_BAR; PG8_SCHED;
            PG8_LDA(At, 1, 1); PG8_STAGE(PG8_SB(1, 0), b3, voffB); PG8_STAGE(PG8_SB(1, 1), b3 + hstepB, voffB); PG8_STAGE(PG8_SA(1, 0), a3, voffA);
            PG8_WAIT_V(8); PG8_WAIT_L(0); PG8_BAR; PG8_MMA(1, 0, At, B0); PG8_MMA(1, 1, At, B1); PG8_BAR; PG8_SCHED;
            } else {
            PG8_LDB(B0, 0, 0); PG8_SCHED; PG8_LDA(At, 0, 0); PG8_STAGE(PG8_SA(1, 1), a1 + hstep, voffA);
            PG8_WAIT_L(8); PG8_BAR; PG8_WAIT_L(0); PG8_MMA(0, 0, At, B0); PG8_BAR; PG8_SCHED;
            PG8_LDB(B1, 0, 1); PG8_STAGE(PG8_SB(0, 0), b2, voffB);
            PG8_BAR; PG8_WAIT_L(0); PG8_MMA(0, 1, At, B1); PG8_BAR;
            PG8_LDA(At, 0, 1); PG8_STAGE(PG8_SA(0, 0), a2, voffA);
            PG8_BAR; PG8_WAIT_L(0); PG8_MMA(1, 0, At, B0); PG8_BAR; PG8_SCHED;
            PG8_STAGE(PG8_SB(0, 1), b2 + hstepB, voffB);
            PG8_WAIT_V(6); PG8_BAR; PG8_MMA(1, 1, At, B1); PG8_BAR;
            PG8_LDB(B0, 1, 0); PG8_SCHED; PG8_LDA(At, 1, 0); PG8_STAGE(PG8_SA(0, 1), a2 + hstep, voffA);
            PG8_WAIT_L(8); PG8_BAR; PG8_WAIT_L(0); PG8_MMA(0, 0, At, B0); PG8_BAR; PG8_SCHED;
            PG8_LDB(B1, 1, 1); PG8_STAGE(PG8_SB(1, 0), b3, voffB);
            PG8_BAR; PG8_WAIT_L(0); PG8_MMA(0, 1, At, B1); PG8_BAR;
            PG8_LDA(At, 1, 1); PG8_STAGE(PG8_SA(1, 0), a3, voffA);
            PG8_BAR; PG8_WAIT_L(0); PG8_MMA(1, 0, At, B0); PG8_BAR; PG8_SCHED;
            PG8_STAGE(PG8_SB(1, 1), b3 + hstepB, voffB);
            PG8_WAIT_V(6); PG8_BAR; PG8_MMA(1, 1, At, B1); PG8_BAR;
            }
        }
        if constexpr (ALIGN_EPI) { if (wr == 0) PG8_BAR; }
        if constexpr (!Epi::AFTER_DRAIN) { E(acc, cur, wr, wc, fr, fq); S.done(cur); }
        if (!has_next) break;
#pragma unroll
        for (int a = 0; a < 2; ++a)
#pragma unroll
            for (int b = 0; b < 2; ++b)
#pragma unroll
                for (int m = 0; m < 4; ++m)
#pragma unroll
                    for (int n = 0; n < 2; ++n) acc[a][b][m][n] = (f32x4){0.f, 0.f, 0.f, 0.f};
        cur = nxt; cA = nA; cB = nB; ++ui;
        if constexpr (ALIGN_EPI) { if (wr == 1) PG8_BAR; }
    }
    PG8_WAIT_V(0);
    if constexpr (!ALIGN_EPI) { if (wr == 0) PG8_BAR; }
    PG8_BAR;
    if constexpr (Epi::AFTER_DRAIN) { E.fused(acc, cur, wr, wc, fr, fq, lds, wid, lane); S.done(cur); }
#undef PG8_SA
#undef PG8_SB
#undef PG8_STAGE
#undef PG8_LDA
#undef PG8_LDB
#undef PG8_MMA
#undef PG8_WAIT_V
#undef PG8_WAIT_L
#undef PG8_BAR
#undef PG8_SCHED
}
}
#define PG8_SP2 true
#define PG8_ALIGN true
#include <hip/hip_bf16.h>
#include <cmath>
namespace attn_body {
using bf16=__hip_bfloat16;
using bf16x8=__attribute__((ext_vector_type(8)))short;
using s16x4=__attribute__((ext_vector_type(4)))short;
using f32x16=__attribute__((ext_vector_type(16)))float;
using u32x4=__attribute__((ext_vector_type(4)))unsigned;
constexpr int BATCH=8,NHEAD=16,SEQ=4096,D=64,DM=NHEAD*D;
constexpr int NW=8,QBLK=32,QB=QBLK*NW,KVBLK=64,NQB=SEQ/QB;
constexpr int ATTN_PITCH=DM, ATTN_UNIT_ROWS=QB;
__device__ __forceinline__ int crow(int r,int hi){return (r&3)+8*(r>>2)+4*hi;}
#define SBAR() __builtin_amdgcn_sched_barrier(0)
__device__ __forceinline__ void cmask(f32x16&p0,f32x16&p1,int jb,int qrel,int hi){
  const float NEG=-INFINITY; int kb=64*jb+4*hi;
  #pragma unroll
  for(int r=0;r<16;++r){int kv=kb+(r&3)+8*(r>>2); if(kv>qrel)p0[r]=NEG; if(kv+32>qrel)p1[r]=NEG;}
}

constexpr int NSLOT=3, SLOTB=8192;
constexpr int LDS_K=0, LDS_V=NSLOT*SLOTB, LDS_WS=2*NSLOT*SLOTB, LDS_OST=LDS_WS+NW*64*4, LDS_KB=LDS_OST+NW*4096, LDS_G=LDS_KB+SEQ*4, LDS_BYTES=LDS_G+NW*4096;
constexpr float C2=0.125f*1.4426950408889634f;
__device__ __forceinline__ void glds16(const void*gsrc,unsigned lds_dst){unsigned keep;
  asm volatile("s_mov_b32 %0, m0\n\ts_mov_b32 m0, %2\n\ts_nop 0\n\tglobal_load_lds_dwordx4 %1, off\n\ts_mov_b32 m0, %0":"=&s"(keep):"v"(gsrc),"s"(lds_dst):"memory");}
__device__ __forceinline__ float max3f(float a,float b,float c){float r;asm("v_max3_f32 %0, %1, %2, %3":"=v"(r):"v"(a),"v"(b),"v"(c));return r;}
__device__ __forceinline__ float max2f(float a,float b){float r;asm("v_max_f32_e32 %0, %1, %2":"=v"(r):"v"(a),"v"(b));return r;}
__device__ __forceinline__ float fadd_s(float a,float b){float r;asm("v_add_f32_e32 %0, %1, %2":"=v"(r):"v"(a),"v"(b));return r;}
__device__ __forceinline__ float fsub_s(float a,float b){float r;asm("v_sub_f32_e32 %0, %1, %2":"=v"(r):"v"(a),"v"(b));return r;}
typedef float f32x2_t __attribute__((ext_vector_type(2))); typedef __bf16 bf16x2_t __attribute__((ext_vector_type(2)));
__device__ __forceinline__ unsigned cvtpk_s(float lo,float hi){f32x2_t v={lo,hi};bf16x2_t b=__builtin_convertvector(v,bf16x2_t);return __builtin_bit_cast(unsigned,b);}
#define WAIT_BAR(N) asm volatile("s_waitcnt vmcnt(" #N ") lgkmcnt(0)\n\ts_barrier":::"memory")

__device__ __forceinline__ void qkt(f32x16&p0,f32x16&p1,const char*Kslot,const bf16x8*qr,const f32x16&negm,int r32,int hi){
  const char*kb=Kslot+hi*1024+r32*16;
  #pragma unroll
  for(int d0=0;d0<4;++d0){
    const bf16x8 b0=*reinterpret_cast<const bf16x8*>(kb+d0*2048);
    const bf16x8 b1=*reinterpret_cast<const bf16x8*>(kb+d0*2048+512);
    if(d0==0){p0=__builtin_amdgcn_mfma_f32_32x32x16_bf16(b0,qr[0],negm,0,0,0);p1=__builtin_amdgcn_mfma_f32_32x32x16_bf16(b1,qr[0],negm,0,0,0);}
    else{p0=__builtin_amdgcn_mfma_f32_32x32x16_bf16(b0,qr[d0],p0,0,0,0);p1=__builtin_amdgcn_mfma_f32_32x32x16_bf16(b1,qr[d0],p1,0,0,0);}}
}
typedef __attribute__((address_space(3))) const char* lds_cptr;
typedef short v4i16_t __attribute__((ext_vector_type(4)));
__device__ __forceinline__ void kload8(bf16x8*kf,lds_cptr kp){
  kf[0]=*(const __attribute__((address_space(3))) bf16x8*)(kp);      kf[1]=*(const __attribute__((address_space(3))) bf16x8*)(kp+512);
  kf[2]=*(const __attribute__((address_space(3))) bf16x8*)(kp+2048); kf[3]=*(const __attribute__((address_space(3))) bf16x8*)(kp+2560);
  kf[4]=*(const __attribute__((address_space(3))) bf16x8*)(kp+4096); kf[5]=*(const __attribute__((address_space(3))) bf16x8*)(kp+4608);
  kf[6]=*(const __attribute__((address_space(3))) bf16x8*)(kp+6144); kf[7]=*(const __attribute__((address_space(3))) bf16x8*)(kp+6656);
}
__device__ __forceinline__ void kload2(bf16x8*kf,lds_cptr kp,int j){ kf[2*j]=*(const __attribute__((address_space(3))) bf16x8*)(kp+j*2048); kf[2*j+1]=*(const __attribute__((address_space(3))) bf16x8*)(kp+j*2048+512); }
__device__ __forceinline__ s16x4 vtr(lds_cptr p){ return __builtin_bit_cast(s16x4,__builtin_amdgcn_ds_read_tr16_b64_v4i16((__attribute__((address_space(3))) v4i16_t*)p)); }
__device__ __forceinline__ float rowmax(const f32x16&p0,const f32x16&p1){
  float a=max3f(p0[0],p0[1],p1[0]),b=max3f(p0[2],p0[3],p1[1]);a=max3f(a,p1[2],p1[3]);
  #pragma unroll
  for(int r=4;r<16;r+=4){a=max3f(a,p0[r],p0[r+1]);b=max3f(b,p0[r+2],p0[r+3]);a=max3f(a,p1[r],p1[r+1]);b=max3f(b,p1[r+2],p1[r+3]);}
  const float m=max2f(a,b);
  auto rr=__builtin_amdgcn_permlane32_swap(__float_as_uint(m),__float_as_uint(m),false,false);
  return max2f(__uint_as_float(rr[0]),__uint_as_float(rr[1]));
}
__device__ __forceinline__ void pv(f32x16*o,int vb,bf16x8 pa0,bf16x8 pa1,bf16x8 pa2,bf16x8 pa3){
  #pragma unroll
  for(int d0=0;d0<2;++d0){s16x4 lo[4],hi[4];
    #pragma unroll
    for(int ks=0;ks<4;++ks){
      asm volatile("ds_read_b64_tr_b16 %0,%1 offset:%c2":"=&v"(lo[ks]):"v"(vb),"i"(d0*4096+ks*1024):"memory");
      asm volatile("ds_read_b64_tr_b16 %0,%1 offset:%c2":"=&v"(hi[ks]):"v"(vb),"i"(d0*4096+ks*1024+512):"memory");}
    asm volatile("s_waitcnt lgkmcnt(0)":::"memory");SBAR();
    #define PK(k) (bf16x8){lo[k][0],lo[k][1],lo[k][2],lo[k][3],hi[k][0],hi[k][1],hi[k][2],hi[k][3]}
    o[d0]=__builtin_amdgcn_mfma_f32_32x32x16_bf16(pa0,PK(0),o[d0],0,0,0);
    o[d0]=__builtin_amdgcn_mfma_f32_32x32x16_bf16(pa1,PK(1),o[d0],0,0,0);
    o[d0]=__builtin_amdgcn_mfma_f32_32x32x16_bf16(pa2,PK(2),o[d0],0,0,0);
    o[d0]=__builtin_amdgcn_mfma_f32_32x32x16_bf16(pa3,PK(3),o[d0],0,0,0);
    #undef PK
  }
}

#ifndef ATTN_STORE16
#define ATTN_STORE16(p,v) (*(u32x4*)(p)=(v))
#endif
typedef float f32x4_t __attribute__((ext_vector_type(4)));
__device__ __forceinline__ float bflo(unsigned v){return __uint_as_float(v<<16);} __device__ __forceinline__ float bfhi(unsigned v){return __uint_as_float(v&0xffff0000u);}
__device__ __forceinline__ unsigned gate2(unsigned ov,unsigned gv){ const float g0=bflo(gv),g1=bfhi(gv); const float s0=__builtin_amdgcn_rcpf(1.f+__builtin_amdgcn_exp2f(-1.4426950408889634f*g0)),s1=__builtin_amdgcn_rcpf(1.f+__builtin_amdgcn_exp2f(-1.4426950408889634f*g1)); return cvtpk_s(bflo(ov)*s0,bfhi(ov)*s1); }
template<int THRL> __device__ __forceinline__ void attn_unit(int b,int h,int qb,const bf16*Q,const bf16*__restrict__ K,const bf16*__restrict__ V,bf16*O,const bf16*__restrict__ Gt,const float*__restrict__ KBg,char*shm){
  int tid_a_=threadIdx.x; asm volatile("":"+v"(tid_a_)); const int tid=tid_a_,lane=tid&63,r32=lane&31,hi=lane>>5; const int wid=__builtin_amdgcn_readfirstlane(tid>>6);
  const long rowbase=(long)b*SEQ; const int q0=qb*QB;
  const bf16*Qw=Q+(rowbase+q0+wid*QBLK)*DM+h*D;
  const bf16*Kh=K+rowbase*DM+h*D,*Vh=V+rowbase*DM+h*D;
  const unsigned lds0=(unsigned)(uintptr_t)shm;
  float*wsf=(float*)(shm+LDS_WS)+wid*64;
  const bf16*ksrc=Kh+(long)lane*DM+wid*8;
  const bf16*vsrc=Vh+(long)(16*(wid&3)+(lane>>2))*DM+(wid>>2)*32+(lane&3)*8;
  const unsigned kdst=lds0+LDS_K+wid*1024, vdst=lds0+LDS_V+wid*1024;
  #define DMA_K(t,slot) glds16(ksrc+(long)(t)*KVBLK*DM,(unsigned)__builtin_amdgcn_readfirstlane(kdst+(slot)))
  #define DMA_V(t,slot) glds16(vsrc+(long)(t)*KVBLK*DM,(unsigned)__builtin_amdgcn_readfirstlane(vdst+(slot)))
  const int vb0=(int)(lds0+LDS_V)+((lane>>4)&1)*32+(lane&3)*8+(4*hi+((lane&15)>>2))*64;
  const char*Kbase=shm+LDS_K; bf16x8 kf[8];
  const lds_cptr shm3=(lds_cptr)shm; const lds_cptr kp0=shm3+LDS_K+hi*1024+r32*16; const lds_cptr vp0=shm3+LDS_V+((lane>>4)&1)*32+(lane&3)*8+(4*hi+((lane&15)>>2))*64;
  { const float*kbrow_=KBg+((long)b*NHEAD+h)*SEQ;
    _Pragma("unroll") for(int j_=0;j_<2;++j_){ const int p_=wid+8*j_; if(p_*256<q0+QB) glds16(kbrow_+p_*256+lane*4,(unsigned)__builtin_amdgcn_readfirstlane(lds0+LDS_KB+p_*1024)); }
    const bf16*Gw_=Gt+(rowbase+q0+wid*QBLK)*DM+h*D;
    _Pragma("unroll") for(int i_=0;i_<4;++i_) glds16(Gw_+(long)(i_*8+(lane>>3))*DM+(lane&7)*8,(unsigned)__builtin_amdgcn_readfirstlane(lds0+LDS_G+wid*4096+i_*1024)); }
  #define KBIAS(P0,P1,t) do{ const __attribute__((address_space(3))) f32x4_t*kp_=(const __attribute__((address_space(3))) f32x4_t*)(shm3+LDS_KB+(t)*256+hi*16); \
    _Pragma("unroll") for(int g_=0;g_<4;++g_){ const f32x4_t b0_=kp_[2*g_],b1_=kp_[8+2*g_]; \
      P0[4*g_]+=b0_[0];P0[4*g_+1]+=b0_[1];P0[4*g_+2]+=b0_[2];P0[4*g_+3]+=b0_[3]; P1[4*g_]+=b1_[0];P1[4*g_+1]+=b1_[1];P1[4*g_+2]+=b1_[2];P1[4*g_+3]+=b1_[3]; } }while(0)
  const int NT=(q0+QB)/KVBLK;
  DMA_K(0,0);DMA_V(0,0);DMA_K(1,SLOTB);
  bf16x8 qr[4];
  #pragma unroll
  for(int d0=0;d0<4;++d0)qr[d0]=*reinterpret_cast<const bf16x8*>(&Qw[(long)r32*DM+d0*16+hi*8]);
  float mhat=0.f,l_reg=0.f;f32x16 o[2];o[0]=f32x16{};o[1]=f32x16{};f32x16 negm=f32x16{};asm volatile("":"+v"(negm));
  const int qrel=wid*QBLK+r32;
  #define CMASK(P0,P1,t) do{int jb_=(t)-(NT-4); if(jb_>=0)cmask(P0,P1,jb_,qrel,hi);}while(0)
  bool resc=false;
  #define START(P0,P1) do{ const float rm=rowmax(P0,P1); resc=false; \
    { const float dl=rm; mhat=fadd_s(mhat,dl); \
      _Pragma("unroll") for(int r=0;r<16;++r){P0[r]=fsub_s(P0[r],dl);P1[r]=fsub_s(P1[r],dl);} \
      _Pragma("unroll") for(int r=0;r<16;++r)negm[r]=-mhat; asm volatile("":"+v"(negm)); } \
    _Pragma("unroll") for(int r=0;r<16;++r)P0[r]=__builtin_amdgcn_exp2f(P0[r]); }while(0)
  #define RESC() do{ if(resc){ asm volatile("s_waitcnt lgkmcnt(0)":::"memory"); \
      _Pragma("unroll") for(int d_=0;d_<2;++d_) _Pragma("unroll") for(int r=0;r<16;++r)o[d_][r]*=wsf[crow(r,hi)]; } }while(0)
  f32x16 pA0,pA1,pB0,pB1;
  int sl_prev=0,sl_cur=0,sl_next=SLOTB;
  #define ROT() do{sl_prev=sl_cur;sl_cur=sl_next;sl_next=(sl_next==(NSLOT-1)*SLOTB)?0:sl_next+SLOTB;}while(0)
  DMA_K(2,2*SLOTB);
  WAIT_BAR(3);
  qkt(pA0,pA1,Kbase,qr,negm,r32,hi);asm volatile("s_nop 15\n\ts_nop 7":"+v"(pA0),"+v"(pA1));KBIAS(pA0,pA1,0);CMASK(pA0,pA1,0);
  START(pA0,pA1);
  _Pragma("unroll") for(int r=0;r<16;++r)pA1[r]=__builtin_amdgcn_exp2f(pA1[r]);
  WAIT_BAR(0);
  DMA_K(3,0);DMA_V(1,SLOTB);
  ROT();
  kload8(kf,kp0+sl_cur);
  WAIT_BAR(2);
  s16x4 vlo[8],vhi[8]; u32x4 pw0,pw1,pw2,pw3;
  #define PKW(P,B) cvtpk_s(P[B],P[B+1])
  #define PAF(k) __builtin_bit_cast(bf16x8,pw##k)
  #define VFR(i) (bf16x8){vlo[i][0],vlo[i][1],vlo[i][2],vlo[i][3],vhi[i][0],vhi[i][1],vhi[i][2],vhi[i][3]}
  #define PIN(x) asm volatile("":"+v"(x))
  #define MX3(a,b,c) __builtin_fmaxf(__builtin_fmaxf((a),(b)),(c))
  #define GAPA(MF,A0,A1,A2,A3,W0,W1,PW) do{ MF; sacc+=A0; sacc+=A1; sacc+=A2; sacc+=A3; PIN(sacc); W0; W1; PIN(PW); SBAR(); }while(0)
  #define EX(v) __builtin_amdgcn_exp2f(v)
  #define GAPB(MF,X,B) do{ MF; X[B]=EX(X[B]); X[B+1]=EX(X[B+1]); X[B+2]=EX(X[B+2]); X[B+3]=EX(X[B+3]); PIN(X); SBAR(); }while(0)
  #define VRD(i) do{ vlo[i]=vtr(vp_+(((i)>>2)*4096+((i)&3)*1024)); vhi[i]=vtr(vp_+(((i)>>2)*4096+((i)&3)*1024+512)); }while(0)
  #define KRD(G,j) do{ if(G){ kload2(kf,kp0+sl_next,j); SBAR(); } }while(0)
  #define STEP(C0,C1,P0,P1,t,GK,GV,GL) do{ SBAR(); \
    const lds_cptr vp_=vp0+sl_prev; \
    VRD(0); SBAR(); float sacc=(P0[0]+P0[1]); \
    GAPA(C0=__builtin_amdgcn_mfma_f32_32x32x16_bf16(kf[0],qr[0],negm,0,0,0), P0[2],P0[3],P0[4],P0[5],     pw0[0]=PKW(P0,0), pw0[1]=PKW(P0,2), pw0); \
    VRD(4); SBAR(); GAPA(C1=__builtin_amdgcn_mfma_f32_32x32x16_bf16(kf[1],qr[0],negm,0,0,0), P0[6],P0[7],P0[8],P0[9],     pw0[2]=PKW(P0,4), pw0[3]=PKW(P0,6), pw0); \
    VRD(1); SBAR(); GAPA(C0=__builtin_amdgcn_mfma_f32_32x32x16_bf16(kf[2],qr[1],C0,0,0,0),   P0[10],P0[11],P0[12],P0[13], pw1[0]=PKW(P0,8), pw1[1]=PKW(P0,10), pw1); \
    VRD(5); SBAR(); GAPA(C1=__builtin_amdgcn_mfma_f32_32x32x16_bf16(kf[3],qr[1],C1,0,0,0),   P0[14],P0[15],P1[0],P1[1],   pw1[2]=PKW(P0,12),pw1[3]=PKW(P0,14), pw1); \
    VRD(2); SBAR(); GAPA(C0=__builtin_amdgcn_mfma_f32_32x32x16_bf16(kf[4],qr[2],C0,0,0,0),   P1[2],P1[3],P1[4],P1[5],     pw2[0]=PKW(P1,0), pw2[1]=PKW(P1,2), pw2); \
    VRD(6); SBAR(); GAPA(C1=__builtin_amdgcn_mfma_f32_32x32x16_bf16(kf[5],qr[2],C1,0,0,0),   P1[6],P1[7],P1[8],P1[9],     pw2[2]=PKW(P1,4), pw2[3]=PKW(P1,6), pw2); \
    VRD(3); SBAR(); GAPA(C0=__builtin_amdgcn_mfma_f32_32x32x16_bf16(kf[6],qr[3],C0,0,0,0),   P1[10],P1[11],P1[12],P1[13], pw3[0]=PKW(P1,8), pw3[1]=PKW(P1,10), pw3); \
    VRD(7); SBAR(); GAPA(C1=__builtin_amdgcn_mfma_f32_32x32x16_bf16(kf[7],qr[3],C1,0,0,0),   P1[14],P1[15],0.f,0.f,       pw3[2]=PKW(P1,12),pw3[3]=PKW(P1,14), pw3); \
    l_reg+=sacc; \
    if(GK){DMA_K((t)+3,sl_cur);} if(GV){DMA_V((t)+1,sl_next);} \
    KBIAS(C0,C1,t); CMASK(C0,C1,t); \
    { float a=MX3(C0[0],C0[1],C1[0]),b=MX3(C0[2],C0[3],C1[1]); a=MX3(a,C1[2],C1[3]); \
      _Pragma("unroll") for(int r=4;r<16;r+=4){a=MX3(a,C0[r],C0[r+1]);b=MX3(b,C0[r+2],C0[r+3]);a=MX3(a,C1[r],C1[r+1]);b=MX3(b,C1[r+2],C1[r+3]);} \
      float rm=__builtin_fmaxf(a,b); { auto rr=__builtin_amdgcn_permlane32_swap(__float_as_uint(rm),__float_as_uint(rm),false,false); rm=__builtin_fmaxf(__uint_as_float(rr[0]),__uint_as_float(rr[1])); } \
      resc=false; \
      if(__builtin_expect(__any(rm>(float)THRL),0)){ const float dl=__builtin_fmaxf(rm,0.f); mhat+=dl; \
        _Pragma("unroll") for(int r=0;r<16;++r){C0[r]-=dl;C1[r]-=dl;} \
        _Pragma("unroll") for(int r=0;r<16;++r)negm[r]=-mhat; asm volatile("":"+v"(negm)); \
        const float f=__builtin_amdgcn_exp2f(-dl); l_reg*=f; if(hi==0)wsf[r32]=f; resc=true; } } \
    SBAR(); \
    GAPB(o[0]=__builtin_amdgcn_mfma_f32_32x32x16_bf16(PAF(0),VFR(0),o[0],0,0,0), C0,0); \
    GAPB(o[1]=__builtin_amdgcn_mfma_f32_32x32x16_bf16(PAF(0),VFR(4),o[1],0,0,0), C0,4); \
    KRD(GL,0); GAPB(o[0]=__builtin_amdgcn_mfma_f32_32x32x16_bf16(PAF(1),VFR(1),o[0],0,0,0), C0,8); \
    KRD(GL,1); GAPB(o[1]=__builtin_amdgcn_mfma_f32_32x32x16_bf16(PAF(1),VFR(5),o[1],0,0,0), C0,12); \
    KRD(GL,2); GAPB(o[0]=__builtin_amdgcn_mfma_f32_32x32x16_bf16(PAF(2),VFR(2),o[0],0,0,0), C1,0); \
    KRD(GL,3); GAPB(o[1]=__builtin_amdgcn_mfma_f32_32x32x16_bf16(PAF(2),VFR(6),o[1],0,0,0), C1,4); \
    GAPB(o[0]=__builtin_amdgcn_mfma_f32_32x32x16_bf16(PAF(3),VFR(3),o[0],0,0,0), C1,8); \
    GAPB(o[1]=__builtin_amdgcn_mfma_f32_32x32x16_bf16(PAF(3),VFR(7),o[1],0,0,0), C1,12); \
    }while(0)
  int t=1;
  #undef CMASK
  #define CMASK(P0,P1,t) do{}while(0)
  for(;t+5<NT;t+=2){
    STEP(pB0,pB1,pA0,pA1,t,true,true,true);     WAIT_BAR(2); RESC(); ROT();
    STEP(pA0,pA1,pB0,pB1,t+1,true,true,true);   WAIT_BAR(2); RESC(); ROT();
  }
  #undef CMASK
  #define CMASK(P0,P1,t) do{int jb_=(t)-(NT-4); if(jb_>=0)cmask(P0,P1,jb_,qrel,hi);}while(0)
  #define ENDW(tt) do{ if((tt)+3<NT){WAIT_BAR(2);} else if((tt)+2<NT){WAIT_BAR(1);} else {WAIT_BAR(0);} }while(0)
  for(;t+1<NT;t+=2){
    STEP(pB0,pB1,pA0,pA1,t,(t+3<NT),(t+1<NT),(t+1<NT));       ENDW(t);   RESC(); ROT();
    STEP(pA0,pA1,pB0,pB1,t+1,(t+4<NT),(t+2<NT),(t+2<NT));     ENDW(t+1); RESC(); ROT();
  }
  STEP(pB0,pB1,pA0,pA1,NT-1,false,false,false); RESC();
  { float sacc=pB0[0]+pB0[1]; _Pragma("unroll") for(int r=2;r<16;++r)sacc+=pB0[r]; _Pragma("unroll") for(int r=0;r<16;++r)sacc+=pB1[r]; l_reg+=sacc;
    pw0=(u32x4){PKW(pB0,0),PKW(pB0,2),PKW(pB0,4),PKW(pB0,6)};pw1=(u32x4){PKW(pB0,8),PKW(pB0,10),PKW(pB0,12),PKW(pB0,14)};pw2=(u32x4){PKW(pB1,0),PKW(pB1,2),PKW(pB1,4),PKW(pB1,6)};pw3=(u32x4){PKW(pB1,8),PKW(pB1,10),PKW(pB1,12),PKW(pB1,14)};
    SBAR(); pv(o,vb0+sl_cur,PAF(0),PAF(1),PAF(2),PAF(3)); }
  #undef PKW
  #undef PAF
  #undef VFR
  #undef PIN
  #undef MX3
  #undef GAPA
  #undef GAPB
  #undef EX
  #undef VRD
  #undef KRD
  #undef STEP
  #undef ENDW
  {auto rr=__builtin_amdgcn_permlane32_swap(__float_as_uint(l_reg),__float_as_uint(l_reg),false,false);l_reg=__uint_as_float(rr[0])+__uint_as_float(rr[1]);}
  if(hi==0)wsf[32+r32]=l_reg;asm volatile("s_waitcnt lgkmcnt(0)":::"memory");
  float rli[16];
  #pragma unroll
  for(int r=0;r<16;++r)rli[r]=__builtin_amdgcn_rcpf(wsf[32+crow(r,hi)]);
  bf16*Ow=O+(rowbase+q0+wid*QBLK)*DM+h*D; const bf16*gstg=(const bf16*)(shm+LDS_G)+wid*2048;
  { bf16*stg=(bf16*)(shm+LDS_OST)+wid*2048;
    #pragma unroll
    for(int r=0;r<16;++r){const int orow=crow(r,hi);
      #pragma unroll
      for(int d0=0;d0<2;++d0)stg[orow*64+d0*32+r32]=__float2bfloat16(o[d0][r]*rli[r]);}
    asm volatile("s_waitcnt lgkmcnt(0)":::"memory");
    #pragma unroll
    for(int i=0;i<4;++i){const int row=i*8+(lane>>3),ch=lane&7; u32x4 v=*(const u32x4*)(stg+row*64+ch*8); const u32x4 gv=*(const u32x4*)(gstg+row*64+ch*8); v.x=gate2(v.x,gv.x);v.y=gate2(v.y,gv.y);v.z=gate2(v.z,gv.z);v.w=gate2(v.w,gv.w); ATTN_STORE16(Ow+(long)row*DM+ch*8,v);} }
  asm volatile("s_waitcnt lgkmcnt(0)\n\ts_barrier":::"memory");
  #undef KBIAS
  #undef DMA_K
  #undef DMA_V
  #undef CMASK
  #undef START
  #undef RESC
  #undef ROT
}
constexpr int ATTN_LDS_BYTES=LDS_BYTES;
struct AttnTensors { const bf16* Q; const bf16* K; const bf16* V; bf16* O; const bf16* G; const float* KB; unsigned long long* ts; };
struct AttnUnit { int bh; int qb; };
struct StaticOrder {
  int vcu;
  int G_;
  __device__ __forceinline__ explicit StaticOrder(int grid,int block):vcu((grid%8==0)?(block%8)*(grid/8)+block/8:block),G_(grid){}
  __device__ __forceinline__ bool next(int i,AttnUnit&u)const{ const int pu=vcu+(i>>1)*G_; if(pu>=BATCH*NHEAD*(NQB/2))return false; const int s=pu%(NQB/2); int bh=pu/(NQB/2); if(G_==256)bh=(bh&~15)|((bh+4*(i>>1))&15); u.bh=bh; u.qb=(i&1)?(NQB-1-s):s; return true; }
  __device__ __forceinline__ void a_ready(const AttnUnit&)const{}
  __device__ __forceinline__ void done(const AttnUnit&)const{}
};
template<class Sched,int THRL=8> __device__ __forceinline__ void attn_phase(char*lds,const AttnTensors&T,const Sched&S){
  AttnUnit u;
  for(int i=0;S.next(i,u);++i){ if(T.ts&&blockIdx.x==0&&threadIdx.x==0)T.ts[32+i]=__builtin_amdgcn_s_memrealtime(); S.a_ready(u); attn_unit<THRL>(u.bh/NHEAD,u.bh%NHEAD,u.qb,T.Q,T.K,T.V,T.O,T.G,T.KB,lds); S.done(u); }
}
#undef SBAR
#undef WAIT_BAR
}
#define GAS __attribute__((address_space(1)))
#define LAS __attribute__((address_space(3)))
typedef unsigned short bf16;
typedef unsigned v4u __attribute__((ext_vector_type(4)));
typedef float f32x4 __attribute__((ext_vector_type(4)));
typedef short bf16x8 __attribute__((ext_vector_type(8)));
typedef GAS unsigned gu32;
typedef GAS unsigned long long gu64;
#define RLX_AGENT __ATOMIC_RELAXED, __HIP_MEMORY_SCOPE_AGENT
#define LDS_WAIT() asm volatile("s_waitcnt lgkmcnt(0)" ::: "memory")
#define VM_WAIT() asm volatile("s_waitcnt vmcnt(0)" ::: "memory")
__device__ __forceinline__ unsigned long long rt() { return __builtin_amdgcn_s_memrealtime(); }
__device__ __forceinline__ unsigned f2bf(float f) { unsigned u = __builtin_bit_cast(unsigned, f); return (u + 0x7fffu + ((u >> 16) & 1u)) >> 16; }
__device__ __forceinline__ unsigned pk2(float lo, float hi) { return f2bf(lo) | (f2bf(hi) << 16); }

#define XB_TMO      128
#define XB_XCNT(j)  (256  + 64 * (j))
#define XB_XSUB(j)  (1280 + 64 * (j))
#define XB_XGEN(j)  (2304 + 64 * (j))
#define XB_TOP      3328
#define XB_TOPGEN   3392
#define XCD_BAR_WORDS 3456
#define XB_SPIN_CAP (1u << 18)

__device__ __forceinline__ unsigned xb_ld(unsigned* p)              { return __hip_atomic_load(p, __ATOMIC_RELAXED, __HIP_MEMORY_SCOPE_AGENT); }
__device__ __forceinline__ unsigned xb_add(unsigned* p, unsigned v) { return __hip_atomic_fetch_add(p, v, __ATOMIC_RELAXED, __HIP_MEMORY_SCOPE_AGENT); }
__device__ __forceinline__ unsigned xb_xcc_id() { return (unsigned)__builtin_amdgcn_s_getreg((3 << 11) | 20) & 0xFu; }
#define XB_SPIN(cond, bar) do { unsigned _sp = 0; while (cond) { __builtin_amdgcn_s_sleep(1); \
    if ((++_sp & 255u) == 0u) { if (xb_ld(&(bar)[XB_TMO])) break; if (_sp > XB_SPIN_CAP) { atomicAdd(&(bar)[XB_TMO], 1u); break; } } } } while (0)

struct XcdBarrier {
    unsigned* bar; unsigned x;
    volatile LAS unsigned* st;
};

__device__ __forceinline__ XcdBarrier xcd_barrier_post(unsigned* bar, volatile LAS unsigned* st) {
    XcdBarrier b; b.bar = bar; b.x = xb_xcc_id(); b.st = st;
    if (threadIdx.x == 0) (void)xb_add(&bar[XB_XCNT(b.x)], 1u);
    return b;
}
__device__ __forceinline__ void xcd_barrier_complete(unsigned* bar, unsigned x, unsigned& nloc, unsigned& nx) {
    const unsigned G = gridDim.x * gridDim.y * gridDim.z;
    unsigned sum, cnt, mine, sp = 0u;
    for (;;) {
        sum = 0u; cnt = 0u; mine = 0u;
#pragma unroll
        for (unsigned j = 0; j < 16; ++j) { const unsigned c = xb_ld(&bar[XB_XCNT(j)]); sum += c; cnt += (c > 0u) ? 1u : 0u; mine = (j == x) ? c : mine; }
        if (sum == G) break;
        __builtin_amdgcn_s_sleep(1);
        if ((++sp & 255u) == 0u) { if (xb_ld(&bar[XB_TMO])) break; if (sp > XB_SPIN_CAP) { atomicAdd(&bar[XB_TMO], 1u); break; } }
    }
    nloc = mine > 0u ? mine : 1u; nx = cnt > 0u ? cnt : 1u;
}

__device__ __forceinline__ void xcd_barrier(const XcdBarrier& b) {
    asm volatile("s_waitcnt vmcnt(0)" ::: "memory");
    __syncthreads();
    if (threadIdx.x == 0) {
        unsigned* bar = b.bar;
        __builtin_amdgcn_s_waitcnt(0);
        unsigned nloc = b.st[0], nx = b.st[1];
        if (nloc == 0u) { xcd_barrier_complete(bar, b.x, nloc, nx); b.st[0] = nloc; b.st[1] = nx; }
        const unsigned old = xb_add(&bar[XB_XSUB(b.x)], 1u);
        const unsigned gen = old / nloc;
        if (old + 1u == (gen + 1u) * nloc) {
            __builtin_amdgcn_fence(__ATOMIC_RELEASE, "agent");
            asm volatile("s_waitcnt vmcnt(0)" ::: "memory");
            const unsigned og = xb_add(&bar[XB_TOP], 1u);
            const unsigned tg = og / nx;
            if (og + 1u == (tg + 1u) * nx) xb_add(&bar[XB_TOPGEN], 1u);
            else XB_SPIN(xb_ld(&bar[XB_TOPGEN]) == tg, bar);
            __builtin_amdgcn_fence(__ATOMIC_ACQUIRE, "agent");
            xb_add(&bar[XB_XGEN(b.x)], 1u);
            asm volatile("s_waitcnt vmcnt(0)" ::: "memory");
        } else {
            XB_SPIN(xb_ld(&bar[XB_XGEN(b.x)]) == gen, bar);
            __builtin_amdgcn_fence(__ATOMIC_ACQUIRE, "agent");
            asm volatile("s_waitcnt vmcnt(0)" ::: "memory");
        }
    }
    __syncthreads();
}
namespace cg = cooperative_groups;
constexpr int NWAVES = 8;
constexpr int BATCH = 8, SEQ = 4096, D = 1024, FF = 4096, M = BATCH * SEQ;
constexpr int N0 = 2816;
constexpr int N1 = 4352;
constexpr int EVEN_IN = 2576, ODD_IN = 4112;
constexpr float LN_EPS = 1e-5f;
constexpr size_t MiB = 1u << 20;
constexpr size_t WS_CTL = 0, CTL_ZERO_BYTES = 1 * MiB;
constexpr size_t WS_MOD = 1 * MiB, WS_BIAS0 = 1 * MiB + 512 * 1024;
constexpr size_t WS_WIN0 = 2 * MiB, WS_WOUT0 = 8 * MiB, WS_W1_0 = 10 * MiB, WS_W2_0 = 18 * MiB, WS_WIN1 = 26 * MiB, WS_WOUT1 = 35 * MiB, WS_W1_1 = 37 * MiB, WS_W2_1 = 45 * MiB;
constexpr size_t WS_RGP = 54 * MiB, WS_RGH = 56 * MiB, WS_RGC = 58 * MiB, WS_GDEC = 60 * MiB, WS_RGWT = 60 * MiB + 512 * 1024, WS_FL = 61 * MiB, WS_KB = 63 * MiB;
constexpr size_t WS_U = 66 * MiB, WS_MIX = 130 * MiB, WS_PROJ = 194 * MiB, WS_GKV = 370 * MiB, WS_END = 450 * MiB;
constexpr size_t QKVG_STRIDE = 64 * MiB / 2;
constexpr int CW_BAR = 4096;
constexpr int RING_BYTES = 143360, LDSCTL_OFF = RING_BYTES, MISC_OFF = LDSCTL_OFF + 320, LDS_BYTES = 147456;
static_assert(attn_body::ATTN_LDS_BYTES <= RING_BYTES, "attention LDS");

struct Frame {
    LAS unsigned char* lds; volatile LAS unsigned* MISC; gu32* ctl;
    int vcu, G;
    unsigned char* ws;
};
__device__ __forceinline__ const float* inp(int i) { const __attribute__((address_space(4))) unsigned long long* k = (const __attribute__((address_space(4))) unsigned long long*)__builtin_amdgcn_kernarg_segment_ptr(); asm volatile("" : "+s"(k)); return (const float*)(const __attribute__((address_space(1))) float*)k[i]; }
#define WSP(T, off) ((T*)(F.ws + (off)))
#define PHASE_IDS int tid_ = threadIdx.x; asm volatile("" : "+v"(tid_)); const int tid = tid_, lane = tid & 63, wave = __builtin_amdgcn_readfirstlane(tid >> 6); (void)lane; (void)wave;
__device__ __forceinline__ float bf2f(bf16 v) { return __uint_as_float((unsigned)v << 16); }
__device__ __forceinline__ float sigmoid_f(float x) { return 1.f / (1.f + __expf(-x)); }
__device__ __forceinline__ float logsigmoid_f(float x) { return fminf(x, 0.f) - log1pf(expf(-fabsf(x))); }
__device__ __forceinline__ float gelu_tanh_f(float x) { return 0.5f * x * (1.f + tanhf(0.7978845608028654f * (x + 0.044715f * x * x * x))); }
__device__ __forceinline__ float wave_sum(float v) {
#pragma unroll
    for (int o = 1; o < 64; o <<= 1) v += __shfl_xor(v, o);
    return v;
}
__device__ __forceinline__ void p0_write_tile(bf16* WT, int K, int row0, int k0, LAS float* scr, int lane) {
    const int c = lane & 7;
#pragma unroll
    for (int j = 0; j < 4; ++j) { const int n = (lane >> 3) + 8 * j; const LAS float* s = scr + (8 * c) * 33 + n;
        v4u o; o.x = pk2(s[0 * 33], s[1 * 33]); o.y = pk2(s[2 * 33], s[3 * 33]); o.z = pk2(s[4 * 33], s[5 * 33]); o.w = pk2(s[6 * 33], s[7 * 33]);
        *(GAS v4u*)(WT + (size_t)(row0 + n) * K + k0 + 8 * c) = o; }
    LDS_WAIT(); asm volatile("" ::: "memory");
}
__device__ __forceinline__ void p0_transpose_item(const float* W, int ldw, int ncols, int K, int nblk, bf16* WT, int row_off, LAS float* scr, int item, int lane) {
    const int kb = item / nblk, nb = item % nblk, k0 = 64 * kb, n0 = 32 * nb; const int n = n0 + (lane & 31);
#pragma unroll 8
    for (int i = 0; i < 32; ++i) { const int kk = 2 * i + (lane >> 5); scr[kk * 33 + (lane & 31)] = (n < ncols) ? W[(size_t)(k0 + kk) * ldw + n] : 0.f; }
    LDS_WAIT(); asm volatile("" ::: "memory");
    p0_write_tile(WT, K, row_off + n0, k0, scr, lane);
}
__device__ __forceinline__ void p0_zup_item(const float* Win, const float* wup, bf16* WT, LAS float* scr, int item, int lane) {
    const int kb = item >> 3, jb = item & 7, k = 64 * kb + lane;
    f32x4 z[4];
#pragma unroll
    for (int q = 0; q < 4; ++q) z[q] = *(const f32x4*)(Win + (size_t)k * EVEN_IN + 2560 + 4 * q);
#pragma unroll 4
    for (int jj = 0; jj < 32; ++jj) { float acc = 0.f;
#pragma unroll
        for (int r = 0; r < 16; ++r) acc += z[r >> 2][r & 3] * wup[r * 256 + 32 * jb + jj];
        scr[lane * 33 + jj] = acc; }
    LDS_WAIT(); asm volatile("" ::: "memory");
    p0_write_tile(WT, D, 2560 + 32 * jb, 64 * kb, scr, lane);
}
__device__ __forceinline__ void p0a_phase(Frame& F) {
    PHASE_IDS
    if (F.vcu < 192) {
        LAS float* sc = (LAS float*)F.lds; LAS float* red = (LAS float*)(F.lds + 32768);
        for (int i = tid; i < BATCH * D; i += NWAVES * 64) { const float cv = inp(1)[i]; sc[i] = cv / (1.f + expf(-cv)); }
        __syncthreads();
        for (int item = F.vcu; item < 192; item += F.G) {
            const int ls = item / 48, cb = item % 48, col = cb * 64 + lane; const float* w = inp(2) + (size_t)ls * D * 3072 + col;
            float acc[8];
#pragma unroll
            for (int b = 0; b < 8; ++b) acc[b] = 0.f;
#pragma unroll 4
            for (int kk = 0; kk < 128; ++kk) { const int k = wave * 128 + kk; const float wv = w[(size_t)k * 3072];
#pragma unroll
                for (int b = 0; b < 8; ++b) acc[b] += sc[b * D + k] * wv; }
#pragma unroll
            for (int b = 0; b < 8; ++b) red[(wave * 8 + b) * 64 + lane] = acc[b];
            __syncthreads();
            { const int b = tid >> 6, l = tid & 63; float s = inp(3)[ls * 3072 + cb * 64 + l];
#pragma unroll
              for (int w8 = 0; w8 < 8; ++w8) s += red[(w8 * 8 + b) * 64 + l];
              WSP(float, WS_MOD)[(size_t)(ls * 8 + b) * 3072 + cb * 64 + l] = s; }
            __syncthreads();
        }
    }
    __syncthreads();
    LAS float* scr = (LAS float*)(F.lds + 49152 + wave * 8448);
    const int gw = F.vcu * NWAVES + wave, NGW = F.G * NWAVES;
    constexpr int I_IN0 = 16 * 80, I_ZUP = 128, I_OUT = 16 * 32, I_W1 = 16 * 128, I_W2 = 64 * 32, I_IN1 = 16 * 129;
    constexpr int NITEMS = I_IN0 + I_ZUP + 2 * I_OUT + 2 * I_W1 + 2 * I_W2 + I_IN1;
    for (int it = gw; it < NITEMS; it += NGW) {
        int r = it;
        if (r < I_IN0) { p0_transpose_item(inp(6), EVEN_IN, 2560, D, 80, WSP(bf16, WS_WIN0), 0, scr, r, lane); continue; } r -= I_IN0;
        if (r < I_ZUP) { p0_zup_item(inp(6), inp(14), WSP(bf16, WS_WIN0), scr, r, lane); continue; } r -= I_ZUP;
        if (r < I_OUT) { p0_transpose_item(inp(17), D, D, D, 32, WSP(bf16, WS_WOUT0), 0, scr, r, lane); continue; } r -= I_OUT;
        if (r < I_OUT) { p0_transpose_item(inp(22), D, D, D, 32, WSP(bf16, WS_WOUT1), 0, scr, r, lane); continue; } r -= I_OUT;
        if (r < I_W1) { p0_transpose_item(inp(23), FF, FF, D, 128, WSP(bf16, WS_W1_0), 0, scr, r, lane); continue; } r -= I_W1;
        if (r < I_W1) { p0_transpose_item(inp(23) + (size_t)D * FF, FF, FF, D, 128, WSP(bf16, WS_W1_1), 0, scr, r, lane); continue; } r -= I_W1;
        if (r < I_W2) { p0_transpose_item(inp(25), D, D, FF, 32, WSP(bf16, WS_W2_0), 0, scr, r, lane); continue; } r -= I_W2;
        if (r < I_W2) { p0_transpose_item(inp(25) + (size_t)FF * D, D, D, FF, 32, WSP(bf16, WS_W2_1), 0, scr, r, lane); continue; } r -= I_W2;
        p0_transpose_item(inp(18), ODD_IN, ODD_IN, D, 129, WSP(bf16, WS_WIN1), 0, scr, r, lane);
    }
    { const int gt = F.vcu * NWAVES * 64 + tid, NGT = F.G * NWAVES * 64; v4u* z = (v4u*)(WSP(bf16, WS_WIN1) + (size_t)4128 * D);
      for (int i = gt; i < (N1 - 4128) * D * 2 / 16; i += NGT) z[i] = (v4u){0u, 0u, 0u, 0u};
      for (int i = gt; i < N0; i += NGT) WSP(float, WS_BIAS0)[i] = (i < 2560) ? 0.f : inp(15)[i - 2560];
      for (int i = gt; i < 2 * 8 * 64 * 64; i += NGT) { const int k = i & 63, j = (i >> 6) & 63, n = (i >> 12) & 7, g = i >> 15; WSP(bf16, WS_RGWT)[i] = (bf16)f2bf((g ? inp(11) : inp(9))[(n * 64 + k) * 64 + j]); } }
}
__device__ __forceinline__ void modulate_phase(Frame& F, const float* x, const float* mod  , bf16* U) {
    PHASE_IDS
    const int gw = F.vcu * NWAVES + wave, NGW = F.G * NWAVES;
    for (int m = gw; m < M; m += NGW) {
        const GAS f32x4* xr = (const GAS f32x4*)(x + (size_t)m * D) + lane; const float* md = mod + (size_t)(m / SEQ) * 3072;
        GAS unsigned long long* o8 = (GAS unsigned long long*)(U + (size_t)m * D) + lane;
#pragma unroll
        for (int j = 0; j < 4; ++j) { const f32x4 v = xr[64 * j]; const f32x4 sh = *(const f32x4*)(md + 4 * lane + 256 * j), scl = *(const f32x4*)(md + D + 4 * lane + 256 * j);
            const f32x4 u = v * (scl + 1.0f) + sh; o8[64 * j] = (unsigned long long)pk2(u.x, u.y) | ((unsigned long long)pk2(u.z, u.w) << 32); }
    }
}
template <bool HAS_NEXT> __device__ __forceinline__ void ln_phase(Frame& F, float* xbuf, const float* g, const float* bb, const float* modn, bf16* U) {
    PHASE_IDS
    const int gw = F.vcu * NWAVES + wave, NGW = F.G * NWAVES;
    for (int m = gw; m < M; m += NGW) {
        GAS f32x4* xr = (GAS f32x4*)(xbuf + (size_t)m * D) + lane;
        f32x4 v[4]; float s = 0.f;
#pragma unroll
        for (int j = 0; j < 4; ++j) { v[j] = xr[64 * j]; s += (v[j].x + v[j].y) + (v[j].z + v[j].w); }
        const float mean = wave_sum(s) * (1.f / D); float s2 = 0.f;
#pragma unroll
        for (int j = 0; j < 4; ++j) { v[j] = v[j] - mean; s2 += (v[j].x * v[j].x + v[j].y * v[j].y) + (v[j].z * v[j].z + v[j].w * v[j].w); }
        const float rstd = 1.f / sqrtf(wave_sum(s2) * (1.f / D) + LN_EPS);
        const float* md = HAS_NEXT ? modn + (size_t)(m / SEQ) * 3072 : nullptr;
        GAS unsigned long long* o8 = (GAS unsigned long long*)(U + (size_t)m * D) + lane;
#pragma unroll
        for (int j = 0; j < 4; ++j) { const int col = 4 * lane + 256 * j; const f32x4 y = v[j] * rstd * *(const f32x4*)(g + col) + *(const f32x4*)(bb + col);
            xr[64 * j] = y;
            if (HAS_NEXT) { const f32x4 u = y * (*(const f32x4*)(md + D + col) + 1.0f) + *(const f32x4*)(md + col); o8[64 * j] = (unsigned long long)pk2(u.x, u.y) | ((unsigned long long)pk2(u.z, u.w) << 32); } }
    }
}
typedef float f32x16 __attribute__((ext_vector_type(16)));
#define MFMA32(a, b, c) __builtin_amdgcn_mfma_f32_32x32x16_bf16((a), (b), (c), 0, 0, 0)
__device__ __forceinline__ bf16x8 ldfrag(const LAS bf16* base, int stride, int row, int k) { return *(const LAS bf16x8*)(base + row * stride + k); }
__device__ __forceinline__ int crow(int reg, int hi) { return (reg & 3) + 8 * (reg >> 2) + 4 * hi; }
__device__ __forceinline__ v4u pack8(const float* f) { v4u o; o.x = pk2(f[0], f[1]); o.y = pk2(f[2], f[3]); o.z = pk2(f[4], f[5]); o.w = pk2(f[6], f[7]); return o; }
__device__ __forceinline__ float fsigmoid(float x) { return __builtin_amdgcn_rcpf(1.f + __expf(-x)); }
constexpr int RG_CH = 128, RG_NCH = SEQ / RG_CH;
template <bool FINAL> __device__ __forceinline__ void rg_pass(Frame& F) {
    PHASE_IDS
    const int r = lane & 31, hh = lane >> 5, cg = lane & 7, tg = lane >> 3;
    LAS bf16* XT = (LAS bf16*)(F.lds + wave * 14336);
    LAS bf16* YT = XT + 64 * 72;
    const int gw = F.vcu * NWAVES + wave, NGW = F.G * NWAVES;
    const bf16* PROJ = WSP(bf16, WS_PROJ); const bf16* RGWT = WSP(bf16, WS_RGWT);
    for (int wu = gw; wu < BATCH * 8 * 2 * RG_NCH; wu += NGW) {
        const int ct = wu & 1, n = (wu >> 1) & 7, ch = (wu >> 4) & (RG_NCH - 1), b = wu >> 9;
        const int c = n * 64 + 32 * ct + r;
        bf16x8 bwa[4], bwx[4], idn[4];
#pragma unroll
        for (int ks = 0; ks < 4; ++ks) { bwa[ks] = *(const bf16x8*)(RGWT + ((size_t)(0 * 8 + n) * 64 + 32 * ct + r) * 64 + 16 * ks + 8 * hh); bwx[ks] = *(const bf16x8*)(RGWT + ((size_t)(1 * 8 + n) * 64 + 32 * ct + r) * 64 + 16 * ks + 8 * hh);
            const int m = 32 * ct + r - 16 * ks - 8 * hh;
#pragma unroll
            for (int jj = 0; jj < 8; ++jj) idn[ks][jj] = (m == jj) ? (short)0x3F80 : (short)0; }
        const float ba = inp(10)[c], bx = inp(12)[c], lsl8 = 8.0f * logsigmoid_f(inp(13)[c]);
        float h = FINAL ? WSP(float, WS_RGC)[(size_t)(b * RG_NCH + ch) * 512 + c] : 0.f, P = 1.f;
#pragma unroll 1
        for (int half = 0; half < 2; ++half) {
            const int tb = ch * RG_CH + 64 * half; const size_t row0 = (size_t)b * SEQ + tb;
            {
                const bf16* xr = PROJ + (row0 + 8 * tg) * N0 + n * 64 + 8 * cg; v4u xraw[11]; v4u yraw[4];
#pragma unroll
                for (int i = 0; i < 11; ++i) xraw[i] = (tb + 8 * tg + i - 3 >= 0) ? *(const v4u*)(xr + (ptrdiff_t)(i - 3) * N0) : (v4u){0u, 0u, 0u, 0u};
                if (FINAL) {
#pragma unroll
                    for (int j = 0; j < 4; ++j) yraw[j] = *(const v4u*)(PROJ + (row0 + (lane >> 2) + 16 * j) * N0 + 512 + n * 64 + 32 * ct + 8 * (lane & 3)); }
                float cw[4][8], cbv[8];
#pragma unroll
                for (int k = 0; k < 4; ++k) { const f32x4 w0 = *(const f32x4*)(inp(7) + k * 512 + n * 64 + 8 * cg), w1 = *(const f32x4*)(inp(7) + k * 512 + n * 64 + 8 * cg + 4);
#pragma unroll
                    for (int e = 0; e < 4; ++e) { cw[k][e] = w0[e]; cw[k][4 + e] = w1[e]; } }
                { const f32x4 b0 = *(const f32x4*)(inp(8) + n * 64 + 8 * cg), b1 = *(const f32x4*)(inp(8) + n * 64 + 8 * cg + 4);
#pragma unroll
                  for (int e = 0; e < 4; ++e) { cbv[e] = b0[e]; cbv[4 + e] = b1[e]; } }
#pragma unroll
                for (int i = 0; i < 8; ++i) { float o8[8];
#pragma unroll
                    for (int j = 0; j < 8; ++j) { float acc = cbv[j];
#pragma unroll
                        for (int k = 0; k < 4; ++k) { const unsigned w = xraw[i + k][j >> 1]; acc += cw[k][j] * ((j & 1) ? __uint_as_float(w & 0xffff0000u) : __uint_as_float(w << 16)); }
                        o8[j] = acc; }
                    *(LAS v4u*)(XT + (8 * tg + i) * 72 + 8 * cg) = pack8(o8); }
                if (FINAL) {
#pragma unroll
                    for (int j = 0; j < 4; ++j) *(LAS v4u*)(YT + ((lane >> 2) + 16 * j) * 40 + 8 * (lane & 3)) = yraw[j]; }
            }
            asm volatile("s_waitcnt lgkmcnt(0)" ::: "memory");
#pragma unroll 1
            for (int tile = 0; tile < 2; ++tile) {
                f32x16 aa = {}, uu = {}, xi = {};
#pragma unroll
                for (int ks = 0; ks < 4; ++ks) { const bf16x8 af = ldfrag(XT, 72, 32 * tile + r, 16 * ks + 8 * hh); aa = MFMA32(af, bwa[ks], aa); uu = MFMA32(af, bwx[ks], uu); xi = MFMA32(af, idn[ks], xi); }
#pragma unroll
                for (int q = 0; q < 16; ++q) { const float rg = fsigmoid(aa[q] + ba), ig = fsigmoid(uu[q] + bx); const float a = __expf(lsl8 * rg); aa[q] = a; uu[q] = sqrtf(fmaxf(1.f - a * a, 0.f)) * (ig * xi[q]); }
                float GA[4], GB[4], PA[4], PB[4];
#pragma unroll
                for (int g = 0; g < 4; ++g) { float A = aa[4 * g], Bv = uu[4 * g];
#pragma unroll
                    for (int e = 1; e < 4; ++e) { A *= aa[4 * g + e]; Bv = aa[4 * g + e] * Bv + uu[4 * g + e]; }
                    GA[g] = A; GB[g] = Bv; PA[g] = __shfl_xor(A, 32); PB[g] = __shfl_xor(Bv, 32); }
                float hs[4];
#pragma unroll
                for (int g = 0; g < 4; ++g) { if (hh == 0) { hs[g] = h; h = GA[g] * h + GB[g]; h = PA[g] * h + PB[g]; } else { h = PA[g] * h + PB[g]; hs[g] = h; h = GA[g] * h + GB[g]; }
                    if (!FINAL) P *= GA[g] * PA[g]; }
                if (FINAL) {
#pragma unroll
                    for (int g = 0; g < 4; ++g) { float hv = hs[g];
#pragma unroll
                        for (int e = 0; e < 4; ++e) { const int q = 4 * g + e; hv = aa[q] * hv + uu[q]; LAS bf16* yp = YT + (32 * tile + crow(q, hh)) * 40 + r; const float y = bf2f(*yp);
                            const float th = 1.f - 2.f * __builtin_amdgcn_rcpf(1.f + __expf(1.5957691216057308f * (y + 0.044715f * y * y * y)));
                            *yp = (bf16)f2bf(hv * 0.5f * y * (1.f + th)); } } }
            }
            asm volatile("s_waitcnt lgkmcnt(0)" ::: "memory");
            if (FINAL) {
#pragma unroll
                for (int j = 0; j < 4; ++j) *(v4u*)(WSP(bf16, WS_MIX) + (row0 + (lane >> 2) + 16 * j) * D + n * 64 + 32 * ct + 8 * (lane & 3)) = *(const LAS v4u*)(YT + ((lane >> 2) + 16 * j) * 40 + 8 * (lane & 3));
                asm volatile("s_waitcnt lgkmcnt(0)" ::: "memory"); }
        }
        if (!FINAL && hh == 0) { WSP(float, WS_RGP)[(size_t)(b * RG_NCH + ch) * 512 + c] = P; WSP(float, WS_RGH)[(size_t)(b * RG_NCH + ch) * 512 + c] = h; }
    }
}
struct GlaRawA { bf16 z[8], k[8], v[16]; };
__device__ __forceinline__ void gla_load_a(GlaRawA& R, const bf16* PROJ, int unit, int tid, int wave) {
    const int bh = unit >> 6, nch = unit & 63, b = bh >> 2, h = bh & 3; const size_t row0 = (size_t)b * SEQ + nch * 64;
    const bf16* p = PROJ + (row0 + 8 * wave) * N0 + h * 64 + (tid & 63);
#pragma unroll
    for (int i = 0; i < 8; ++i) { R.z[i] = p[(size_t)i * N0 + 2560]; R.k[i] = p[(size_t)i * N0 + 1280]; }
    const bf16* pv = PROJ + (row0 + 16 * (tid >> 7)) * N0 + 1536 + h * 128 + (tid & 127);
#pragma unroll
    for (int i = 0; i < 16; ++i) R.v[i] = pv[(size_t)i * N0];
}
__device__ __forceinline__ void gla_pass_a(Frame& F) {
    PHASE_IDS
    const int r = lane & 31, hh = lane >> 5;
    LAS bf16* KET = (LAS bf16*)F.lds; LAS bf16* VT = (LAS bf16*)(F.lds + 9216); LAS float* ESUM = (LAS float*)(F.lds + 27648);
    const bf16* PROJ = WSP(bf16, WS_PROJ);
    constexpr int NU = BATCH * 4 * 64;
    GlaRawA R;
    if (F.vcu < NU) gla_load_a(R, PROJ, F.vcu, tid, wave);
    for (int unit = F.vcu; unit < NU; unit += F.G) {
        const int d = tid & 63, te = wave;
        float la[8], kk[8];
#pragma unroll
        for (int i = 0; i < 8; ++i) { la[i] = logsigmoid_f(bf2f(R.z[i])) * (1.f / 16.f); kk[i] = bf2f(R.k[i]); }
#pragma unroll
        for (int i = 1; i < 8; ++i) la[i] += la[i - 1];
        ESUM[te * 64 + d] = la[7];
        { const int v = tid & 127, tq = tid >> 7; float vv[16];
#pragma unroll
          for (int i = 0; i < 16; ++i) vv[i] = bf2f(R.v[i]);
          *(LAS v4u*)(VT + v * 72 + 16 * tq) = pack8(vv); *(LAS v4u*)(VT + v * 72 + 16 * tq + 8) = pack8(vv + 8); }
        if (unit + F.G < NU) gla_load_a(R, PROJ, unit + F.G, tid, wave);
        __syncthreads();
        { float pre = 0.f, bl = 0.f;
#pragma unroll
          for (int e = 0; e < 8; ++e) { const float sv = ESUM[e * 64 + d]; bl += sv; if (e < te) pre += sv; }
          float ke[8];
#pragma unroll
          for (int i = 0; i < 8; ++i) ke[i] = kk[i] * __expf(bl - (pre + la[i]));
          *(LAS v4u*)(KET + d * 72 + 8 * te) = pack8(ke);
          if (te == 0) WSP(float, WS_GDEC)[(size_t)unit * 64 + d] = __expf(bl); }
        __syncthreads();
        { const int tm = wave >> 2, tn = wave & 3; f32x16 acc = {};
#pragma unroll
          for (int ks = 0; ks < 4; ++ks) acc = MFMA32(ldfrag(KET, 72, 32 * tm + r, 16 * ks + 8 * hh), ldfrag(VT, 72, 32 * tn + r, 16 * ks + 8 * hh), acc);
          float* kvp = WSP(float, WS_GKV) + (size_t)unit * 8192 + 32 * tn + r;
#pragma unroll
          for (int q = 0; q < 16; ++q) kvp[(32 * tm + crow(q, hh)) * 128] = acc[q]; }
        __syncthreads();
    }
}
struct GlaRawC { bf16 z[8], k[8], q[8], v[16]; float s[16]; v4u g0, g1; };
__device__ __forceinline__ void gla_load_c(GlaRawC& R, const bf16* PROJ, const float* KV, int unit, int tid, int wave) {
    const int bh = unit >> 6, nch = unit & 63, b = bh >> 2, h = bh & 3; const size_t row0 = (size_t)b * SEQ + nch * 64;
    const bf16* p = PROJ + (row0 + 8 * wave) * N0 + h * 64 + (tid & 63);
#pragma unroll
    for (int i = 0; i < 8; ++i) { R.z[i] = p[(size_t)i * N0 + 2560]; R.k[i] = p[(size_t)i * N0 + 1280]; R.q[i] = p[(size_t)i * N0 + 1024]; }
    const bf16* pv = PROJ + (row0 + 16 * (tid >> 7)) * N0 + 1536 + h * 128 + (tid & 127);
#pragma unroll
    for (int i = 0; i < 16; ++i) R.v[i] = pv[(size_t)i * N0];
    const float* sp = KV + (size_t)unit * 8192 + (16 * (tid >> 7)) * 128 + (tid & 127);
#pragma unroll
    for (int i = 0; i < 16; ++i) R.s[i] = sp[i * 128];
    const v4u* gp = (const v4u*)(PROJ + (row0 + (tid >> 3)) * N0 + 2048 + h * 128 + 16 * (tid & 7)); R.g0 = gp[0]; R.g1 = gp[1];
}
__device__ __forceinline__ void gla_pass_c(Frame& F) {
    PHASE_IDS
    const int r = lane & 31, hh = lane >> 5;
    LAS bf16* QD = (LAS bf16*)F.lds; LAS bf16* KD = (LAS bf16*)(F.lds + 9216); LAS bf16* ATT = (LAS bf16*)(F.lds + 18432); LAS bf16* VT = (LAS bf16*)(F.lds + 27648); LAS bf16* ST = (LAS bf16*)(F.lds + 46080);
    LAS bf16* GT = (LAS bf16*)(F.lds + 64512); LAS float* ESUM = (LAS float*)(F.lds + 81408); LAS float* PART = (LAS float*)(F.lds + 83456);
    const bf16* PROJ = WSP(bf16, WS_PROJ); const float* KV = WSP(float, WS_GKV);
    constexpr int NU = BATCH * 4 * 64;
    GlaRawC R;
    if (F.vcu < NU) gla_load_c(R, PROJ, KV, F.vcu, tid, wave);
    for (int unit = F.vcu; unit < NU; unit += F.G) {
        const int bh = unit >> 6, nch = unit & 63, b = bh >> 2, h = bh & 3; const size_t row0 = (size_t)b * SEQ + nch * 64;
        const int d = tid & 63, te = wave;
        float la[8], kk[8], qq[8];
#pragma unroll
        for (int i = 0; i < 8; ++i) { la[i] = logsigmoid_f(bf2f(R.z[i])) * (1.f / 16.f); kk[i] = bf2f(R.k[i]); qq[i] = bf2f(R.q[i]) * 0.125f; }
#pragma unroll
        for (int i = 1; i < 8; ++i) la[i] += la[i - 1];
        ESUM[te * 64 + d] = la[7];
        { const int v = tid & 127, tq = tid >> 7; float vv[16];
#pragma unroll
          for (int i = 0; i < 16; ++i) vv[i] = bf2f(R.v[i]);
          *(LAS v4u*)(VT + v * 72 + 16 * tq) = pack8(vv); *(LAS v4u*)(VT + v * 72 + 16 * tq + 8) = pack8(vv + 8);
          *(LAS v4u*)(ST + v * 72 + 16 * tq) = pack8(R.s); *(LAS v4u*)(ST + v * 72 + 16 * tq + 8) = pack8(R.s + 8); }
        { const int t = tid >> 3, vc = tid & 7; LAS unsigned long long* dst = (LAS unsigned long long*)(GT + t * 132 + 16 * vc);
          dst[0] = (unsigned long long)R.g0.x | ((unsigned long long)R.g0.y << 32); dst[1] = (unsigned long long)R.g0.z | ((unsigned long long)R.g0.w << 32);
          dst[2] = (unsigned long long)R.g1.x | ((unsigned long long)R.g1.y << 32); dst[3] = (unsigned long long)R.g1.z | ((unsigned long long)R.g1.w << 32); }
        if (unit + F.G < NU) gla_load_c(R, PROJ, KV, unit + F.G, tid, wave);
        __syncthreads();
        { float pre = 0.f;
#pragma unroll
          for (int e = 0; e < 8; ++e) { const float sv = ESUM[e * 64 + d]; if (e < te) pre += sv; }
#pragma unroll
          for (int i = 0; i < 8; ++i) { const float bc = pre + la[i]; QD[(8 * te + i) * 72 + d] = (bf16)f2bf(qq[i] * __expf(bc)); KD[(8 * te + i) * 72 + d] = (bf16)f2bf(kk[i] * __expf(-bc)); } }
        __syncthreads();
        if (wave < 3) { const int tm = (wave + 1) >> 1, tn = wave >> 1;
          f32x16 acc = {};
#pragma unroll
          for (int ks = 0; ks < 4; ++ks) acc = MFMA32(ldfrag(QD, 72, 32 * tm + r, 16 * ks + 8 * hh), ldfrag(KD, 72, 32 * tn + r, 16 * ks + 8 * hh), acc);
#pragma unroll
          for (int q = 0; q < 16; ++q) { const int t = 32 * tm + crow(q, hh), s_ = 32 * tn + r; ATT[t * 72 + s_] = (bf16)f2bf((t >= s_) ? acc[q] : 0.f); } }
        __syncthreads();
        const int tm = wave >> 1, tn = wave & 1;
        f32x16 acc = {};
        if (tn == 0) {
#pragma unroll
            for (int ks = 0; ks < 2; ++ks) acc = MFMA32(ldfrag(VT, 72, 32 * tm + r, 16 * ks + 8 * hh), ldfrag(ATT, 72, r, 16 * ks + 8 * hh), acc);
        } else {
#pragma unroll
            for (int ks = 0; ks < 4; ++ks) acc = MFMA32(ldfrag(VT, 72, 32 * tm + r, 16 * ks + 8 * hh), ldfrag(ATT, 72, 32 + r, 16 * ks + 8 * hh), acc);
        }
#pragma unroll
        for (int ks = 0; ks < 4; ++ks) acc = MFMA32(ldfrag(ST, 72, 32 * tm + r, 16 * ks + 8 * hh), ldfrag(QD, 72, 32 * tn + r, 16 * ks + 8 * hh), acc);
        { float ssq = 0.f;
#pragma unroll
          for (int q = 0; q < 16; ++q) ssq += acc[q] * acc[q];
          ssq += __shfl_xor(ssq, 32); if (hh == 0) PART[tm * 64 + 32 * tn + r] = ssq; }
        __syncthreads();
        { const int t = 32 * tn + r; const float tot = (PART[t] + PART[64 + t]) + (PART[128 + t] + PART[192 + t]); const float ri = 1.f / sqrtf(tot * (1.f / 128.f) + 1e-6f);
          const float* gn = inp(16) + h * 128 + 32 * tm + 4 * hh;
#pragma unroll
          for (int g = 0; g < 4; ++g) { const f32x4 gv = *(const f32x4*)(gn + 8 * g);
#pragma unroll
              for (int e = 0; e < 4; ++e) { const int q = 4 * g + e, v = 32 * tm + crow(q, hh); const float gg = bf2f(GT[t * 132 + v]); GT[t * 132 + v] = (bf16)f2bf(acc[q] * ri * gv[e] * (gg * fsigmoid(gg))); } } }
        __syncthreads();
        { const int t = tid >> 3, vc = tid & 7; const LAS unsigned long long* src = (const LAS unsigned long long*)(GT + t * 132 + 16 * vc); const unsigned long long a0 = src[0], a1 = src[1], a2 = src[2], a3 = src[3];
          v4u* op = (v4u*)(WSP(bf16, WS_MIX) + (row0 + t) * D + 512 + h * 128 + 16 * vc);
          op[0] = (v4u){(unsigned)a0, (unsigned)(a0 >> 32), (unsigned)a1, (unsigned)(a1 >> 32)}; op[1] = (v4u){(unsigned)a2, (unsigned)(a2 >> 32), (unsigned)a3, (unsigned)(a3 >> 32)}; }
        __syncthreads();
    }
}
__device__ __forceinline__ void chunk_scan_phase(Frame& F) {
    PHASE_IDS
    const int gt = F.vcu * NWAVES * 64 + tid, NGT = F.G * NWAVES * 64;
    float* KV = WSP(float, WS_GKV); const float* DEC = WSP(float, WS_GDEC);
    for (int idx = gt; idx < 32 * 8192; idx += NGT) {
        const int bh = idx >> 13, r = idx & 8191, dk = r >> 7; float S = 0.f;
#pragma unroll 1
        for (int n0 = 0; n0 < 64; n0 += 8) { float kv[8], dc[8];
#pragma unroll
            for (int q = 0; q < 8; ++q) { kv[q] = KV[((size_t)(bh * 64 + n0 + q)) * 8192 + r]; dc[q] = DEC[(bh * 64 + n0 + q) * 64 + dk]; }
#pragma unroll
            for (int q = 0; q < 8; ++q) { KV[((size_t)(bh * 64 + n0 + q)) * 8192 + r] = S; S = dc[q] * S + kv[q]; } }
    }
    const float* P = WSP(float, WS_RGP); const float* H = WSP(float, WS_RGH); float* C = WSP(float, WS_RGC);
    for (int idx = gt; idx < BATCH * 512; idx += NGT) {
        const int b = idx >> 9, c = idx & 511; float h = 0.f;
#pragma unroll 1
        for (int n0 = 0; n0 < RG_NCH; n0 += 8) { float pv[8], hv[8];
#pragma unroll
            for (int q = 0; q < 8; ++q) { pv[q] = P[(size_t)(b * RG_NCH + n0 + q) * 512 + c]; hv[q] = H[(size_t)(b * RG_NCH + n0 + q) * 512 + c]; }
#pragma unroll
            for (int q = 0; q < 8; ++q) { C[(size_t)(b * RG_NCH + n0 + q) * 512 + c] = h; h = pv[q] * h + hv[q]; } }
    }
}
__device__ __forceinline__ void fcum_phase(Frame& F) {
    PHASE_IDS
    LAS float* wsum = (LAS float*)F.lds;
    for (int bh = F.vcu; bh < BATCH * 16; bh += F.G) {
        const int b = bh >> 4, h = bh & 15; const float bf = inp(19)[h]; const float* fl = WSP(float, WS_FL) + ((size_t)b * SEQ + 8 * tid) * 16 + h;
        float v[8]; float s = 0.f;
#pragma unroll
        for (int e = 0; e < 8; ++e) { v[e] = logsigmoid_f(fl[e * 16] + bf); s += v[e]; }
        float incl = s;
#pragma unroll
        for (int o = 1; o < 64; o <<= 1) { const float t = __shfl_up(incl, o); if (lane >= o) incl += t; }
        if (lane == 63) wsum[wave] = incl;
        __syncthreads();
        float run = incl - s;
#pragma unroll
        for (int w = 0; w < 8; ++w) if (w < wave) run += wsum[w];
        f32x4 o0, o1;
#pragma unroll
        for (int e = 0; e < 4; ++e) { run += v[e]; o0[e] = -1.4426950408889634f * run; }
#pragma unroll
        for (int e = 0; e < 4; ++e) { run += v[4 + e]; o1[e] = -1.4426950408889634f * run; }
        float* kb = WSP(float, WS_KB) + (size_t)bh * SEQ + 8 * tid; *(f32x4*)kb = o0; *(f32x4*)(kb + 4) = o1;
        __syncthreads();
    }
}
struct Args { const float* in[27]; float* out; unsigned char* ws; };
__global__ void __launch_bounds__(NWAVES * 64, 2) mega_fwd(Args args) {
    extern __shared__ __attribute__((aligned(16))) unsigned char lds[];
    Frame F;
    F.lds = (LAS unsigned char*)lds; F.MISC = (volatile LAS unsigned*)(F.lds + MISC_OFF);
    F.G = gridDim.x; { const int bx = blockIdx.x; F.vcu = (F.G % 8 == 0) ? (bx % 8) * (F.G / 8) + bx / 8 : bx; }
    F.ws = args.ws; F.ctl = (gu32*)(args.ws + WS_CTL);
    for (int u = threadIdx.x; u < (LDS_BYTES - LDSCTL_OFF) / 4; u += NWAVES * 64) ((LAS unsigned*)(F.lds + LDSCTL_OFF))[u] = 0u;
    __syncthreads();
    XcdBarrier bar = xcd_barrier_post((unsigned*)(F.ctl + CW_BAR), F.MISC + 8);
#ifdef PROBE_A0
    unsigned long long* const ts_ = (unsigned long long*)(F.ctl + 2048); int tsn_ = 0;
#define TS() do { if (blockIdx.x == 0 && threadIdx.x == 0) ts_[tsn_] = __builtin_amdgcn_s_memrealtime(); ++tsn_; } while (0)
#else
#define TS() do { } while (0)
#endif
    TS();
#define GRID_BAR() do { xcd_barrier(bar); TS(); } while (0)
#define MODP(l, s) (WSP(float, WS_MOD) + (size_t)((l) * 2 + (s)) * BATCH * 3072)
#define GEMM_MULTI(EpiT, E, Aop, Bop, Nn, Kk) do { pg8::Gemm g_{(const pg8::bf16_t*)(Aop), (const pg8::bf16_t*)(Bop), M, (Nn), (Kk)}; pg8::StaticOrder S_; S_.init(M, (Nn), F.G, (int)blockIdx.x); \
        pg8::gemm_phase<EpiT, pg8::StaticOrder, PG8_ALIGN, PG8_SP2>(F.lds, g_, S_, (E)); } while (0)

    p0a_phase(F);
    cg::this_grid().sync(); TS();
    modulate_phase(F, inp(0), MODP(0, 0), WSP(bf16, WS_U));
    GRID_BAR();
    { pg8::EpiBf16<0> E{(pg8::bf16_t*)WSP(bf16, WS_PROJ), N0, WSP(float, WS_BIAS0), 0, 0, 1.f}; GEMM_MULTI(pg8::EpiBf16<0>, E, WSP(bf16, WS_U), WSP(bf16, WS_WIN0), N0, D); }
    GRID_BAR();
    rg_pass<false>(F); __syncthreads(); gla_pass_a(F);
    GRID_BAR();
    chunk_scan_phase(F);
    GRID_BAR();
    rg_pass<true>(F); __syncthreads(); gla_pass_c(F);
    GRID_BAR();
    { pg8::EpiResid E{inp(0), ((float*)inp(27)), nullptr, MODP(0, 0)}; GEMM_MULTI(pg8::EpiResid, E, WSP(bf16, WS_MIX), WSP(bf16, WS_WOUT0), D, D); }
    GRID_BAR();
    ln_phase<true>(F, ((float*)inp(27)), inp(4), inp(5), MODP(0, 1), WSP(bf16, WS_U));
    GRID_BAR();
    { pg8::EpiBf16<2> E{(pg8::bf16_t*)WSP(bf16, WS_PROJ), FF, inp(24), 0, 0, 1.f}; GEMM_MULTI(pg8::EpiBf16<2>, E, WSP(bf16, WS_U), WSP(bf16, WS_W1_0), FF, D); }
    GRID_BAR();
    { pg8::EpiResid E{((float*)inp(27)), ((float*)inp(27)), inp(26), MODP(0, 1)}; GEMM_MULTI(pg8::EpiResid, E, WSP(bf16, WS_PROJ), WSP(bf16, WS_W2_0), D, FF); }
    GRID_BAR();
    ln_phase<true>(F, ((float*)inp(27)), inp(4) + D, inp(5) + D, MODP(1, 0), WSP(bf16, WS_U));
    GRID_BAR();
    { pg8::EpiQKVG E{(pg8::bf16_t*)WSP(bf16, WS_PROJ), QKVG_STRIDE, WSP(float, WS_FL), inp(20), inp(21), attn_body::C2}; GEMM_MULTI(pg8::EpiQKVG, E, WSP(bf16, WS_U), WSP(bf16, WS_WIN1), N1, D); }
    GRID_BAR();
    fcum_phase(F);
    GRID_BAR();
    { const attn_body::AttnTensors AT{(const attn_body::bf16*)WSP(bf16, WS_PROJ), (const attn_body::bf16*)(WSP(bf16, WS_PROJ) + QKVG_STRIDE), (const attn_body::bf16*)(WSP(bf16, WS_PROJ) + 2 * QKVG_STRIDE),
                                      (attn_body::bf16*)WSP(bf16, WS_PROJ), (const attn_body::bf16*)(WSP(bf16, WS_PROJ) + 3 * QKVG_STRIDE), WSP(float, WS_KB),
#ifdef PROBE_A0
                                      (unsigned long long*)(F.ctl + 2048)
#else
                                      nullptr
#endif
      };
      const attn_body::StaticOrder S((int)F.G, (int)blockIdx.x);
      attn_body::attn_phase<attn_body::StaticOrder, 20>((char*)lds, AT, S); }
    GRID_BAR();
    { pg8::EpiResid E{((float*)inp(27)), ((float*)inp(27)), nullptr, MODP(1, 0)}; GEMM_MULTI(pg8::EpiResid, E, WSP(bf16, WS_PROJ), WSP(bf16, WS_WOUT1), D, D); }
    GRID_BAR();
    ln_phase<true>(F, ((float*)inp(27)), inp(4) + 2 * D, inp(5) + 2 * D, MODP(1, 1), WSP(bf16, WS_U));
    GRID_BAR();
    { pg8::EpiBf16<2> E{(pg8::bf16_t*)WSP(bf16, WS_PROJ), FF, inp(24) + FF, 0, 0, 1.f}; GEMM_MULTI(pg8::EpiBf16<2>, E, WSP(bf16, WS_U), WSP(bf16, WS_W1_1), FF, D); }
    GRID_BAR();
    { pg8::EpiResid E{((float*)inp(27)), ((float*)inp(27)), inp(26) + D, MODP(1, 1)}; GEMM_MULTI(pg8::EpiResid, E, WSP(bf16, WS_PROJ), WSP(bf16, WS_W2_1), D, FF); }
    GRID_BAR();
    ln_phase<false>(F, ((float*)inp(27)), inp(4) + 3 * D, inp(5) + 3 * D, nullptr, WSP(bf16, WS_U));
#ifdef PROBE_A0
    asm volatile("s_waitcnt vmcnt(0)" ::: "memory"); __syncthreads(); TS();
    if (blockIdx.x == 0) {
        __syncthreads();
        float* o = (float*)inp(27);
        const float ta = (float)(ts_[PROBE_A1] - ts_[PROBE_A0]) * 0.01f, tr = (float)(ts_[PROBE_R1] - ts_[PROBE_R0]) * 0.01f;
        const float dl = sqrtf(tr / 4000.f);
        for (int i = threadIdx.x; i < 8192; i += NWAVES * 64) o[i] += (i == 0) ? (ta / 64.f) : dl;
    }
#endif
}

extern "C" void kernel_launch(void* const* d_in, const int* in_sizes, int n_in, void* d_out, int out_size, void* d_ws, size_t ws_size, hipStream_t stream) {
    static int grid = 0;
    if (grid == 0) {
        if (n_in != 27 || in_sizes[0] != M * D || out_size != M * D || ws_size < WS_END) { fprintf(stderr, "kernel_launch: unexpected shapes (n_in %d, in0 %d, out %d, ws %zu); nothing launched\n", n_in, n_in > 0 ? in_sizes[0] : -1, out_size, ws_size); grid = -1; return; }
        int dev = 0, cus = 0, per_cu = 0;
        if (hipGetDevice(&dev) != hipSuccess || hipDeviceGetAttribute(&cus, hipDeviceAttributeMultiprocessorCount, dev) != hipSuccess) { grid = -1; return; }
        if (hipFuncSetAttribute((const void*)mega_fwd, hipFuncAttributeMaxDynamicSharedMemorySize, LDS_BYTES) != hipSuccess) { fprintf(stderr, "kernel_launch: hipFuncSetAttribute failed\n"); grid = -1; return; }
        if (hipOccupancyMaxActiveBlocksPerMultiprocessor(&per_cu, (const void*)mega_fwd, NWAVES * 64, LDS_BYTES) != hipSuccess || per_cu < 1) { fprintf(stderr, "kernel_launch: occupancy query says %d blocks per CU; nothing launched\n", per_cu); (void)hipGetLastError(); grid = -1; return; }
        grid = cus * per_cu;
    }
    if (grid < 0) return;
    if (hipMemsetAsync((char*)d_ws + WS_CTL, 0, CTL_ZERO_BYTES, stream) != hipSuccess) { fprintf(stderr, "kernel_launch: memset failed\n"); return; }
    Args a{};
    for (int i = 0; i < 27; ++i) a.in[i] = (const float*)d_in[i];
    a.out = (float*)d_out; a.ws = (unsigned char*)d_ws;
    void* kargs[] = {&a};
    const hipError_t e = hipLaunchCooperativeKernel((const void*)mega_fwd, dim3(grid), dim3(NWAVES * 64), kargs, LDS_BYTES, stream);
    if (e != hipSuccess) fprintf(stderr, "kernel_launch: cooperative launch failed: %s (grid %d)\n", hipGetErrorString(e), grid);
}
```
